# Optimizing an MI355X kernel written in HIP

```python
import jax, jax.numpy as jnp
from jax import lax
import numpy as np

D_MODEL = 1024
BATCH = 8
SEQ = 4096
DEPTH = 2

CHUNK = 64
Q_BLOCK = 128
P_DIM = 256
MLA_HEADS = 8
MLA_NOPE = 64
MLA_ROPE = 32
MLA_V = 64
Q_LORA = 256
KV_LORA = 256
ROPE_BASE = 10000.0
SB_HEADS = 8
SB_DIM = 64
FOX_HEADS = 16
FOX_DIM = 64
D_FF = ((-(-8 * D_MODEL // 3)) + 255) // 256 * 256
DEEPNORM_ALPHA = (2.0 * DEPTH) ** 0.25
DEEPNORM_BETA = (8.0 * DEPTH) ** -0.25
N_EVEN = (DEPTH + 1) // 2
N_ODD = DEPTH // 2
IN_A = Q_LORA + KV_LORA + MLA_ROPE
IN_B = 3 * SB_HEADS * SB_DIM
IN_C = 3 * FOX_HEADS * FOX_DIM + FOX_HEADS
MIX_A = MLA_HEADS * MLA_V + SB_HEADS * SB_DIM
MIX_C = FOX_HEADS * FOX_DIM

kernel_name = "hybrid_mla_stickbreak_fox_deepnorm"


def layer_norm(x, g, b, eps=1e-5):
    xf = x.astype(jnp.float32)
    mu = jnp.mean(xf, -1, keepdims=True)
    var = jnp.mean(jnp.square(xf - mu), -1, keepdims=True)
    return ((xf - mu) * lax.rsqrt(var + eps) * g + b).astype(x.dtype)


def rms_norm(x, g, eps=1e-6):
    xf = x.astype(jnp.float32)
    return (xf * lax.rsqrt(jnp.mean(jnp.square(xf), -1, keepdims=True) + eps) * g).astype(x.dtype)


def rope_tables(seq, dim):
    inv = 1.0 / (ROPE_BASE ** (jnp.arange(0, dim, 2, dtype=jnp.float32) / dim))
    ang = jnp.arange(seq, dtype=jnp.float32)[:, None] * inv[None, :]
    return jnp.cos(ang), jnp.sin(ang)


def apply_rope(x, cos, sin):
    x1, x2 = jnp.split(x, 2, axis=-1)
    return jnp.concatenate([x1 * cos - x2 * sin, x1 * sin + x2 * cos], -1).astype(x.dtype)


def sweep_query_blocks(block_fn, q):
    b, h, s, d = q.shape
    nb = s // Q_BLOCK
    q_blocks = q.reshape(b, h, nb, Q_BLOCK, d).transpose(2, 0, 1, 3, 4)
    out = lax.map(lambda a: block_fn(a[0], a[1]), (q_blocks, jnp.arange(nb)))
    dv = out.shape[-1]
    return out.transpose(1, 0, 3, 2, 4).reshape(b, s, h * dv)


def mla_block(q_blk, blk, k, v):
    t = blk * Q_BLOCK + jnp.arange(Q_BLOCK)
    s = jnp.arange(k.shape[2])
    allowed = (s[None, :] // CHUNK) <= (t[:, None] // CHUNK)
    logits = jnp.einsum('bhqd,bhkd->bhqk', q_blk, k).astype(jnp.float32) * (MLA_NOPE + MLA_ROPE) ** -0.5
    w = jax.nn.softmax(jnp.where(allowed, logits, -jnp.inf), axis=-1)
    return jnp.einsum('bhqk,bhkd->bhqd', w.astype(v.dtype), v)


def stick_breaking_block(q_blk, blk, k, v):
    t = blk * Q_BLOCK + jnp.arange(Q_BLOCK)
    s = jnp.arange(k.shape[2])
    past = s[None, :] < t[:, None]
    z = jnp.einsum('bhqd,bhkd->bhqk', q_blk, k).astype(jnp.float32) * SB_DIM ** -0.5
    log_beta = jax.nn.log_sigmoid(z)
    log_rem = jnp.where(past, jax.nn.log_sigmoid(-z), 0.0)
    between = lax.cumsum(log_rem, axis=3, reverse=True) - log_rem
    att = jnp.where(past, jnp.exp(log_beta + between), 0.0)
    return jnp.einsum('bhqk,bhkd->bhqd', att.astype(v.dtype), v)


def forgetting_block(q_blk, blk, k, v, dcum):
    t = blk * Q_BLOCK + jnp.arange(Q_BLOCK)
    s = jnp.arange(k.shape[2])
    causal = s[None, :] <= t[:, None]
    d_t = lax.dynamic_slice_in_dim(dcum, blk * Q_BLOCK, Q_BLOCK, axis=2)
    logits = (jnp.einsum('bhqd,bhkd->bhqk', q_blk, k).astype(jnp.float32) * FOX_DIM ** -0.5
              + d_t[..., :, None] - dcum[..., None, :])
    w = jax.nn.softmax(jnp.where(causal, logits, -jnp.inf), axis=-1)
    return jnp.einsum('bhqk,bhkd->bhqd', w.astype(v.dtype), v)


def mixer_mla_sb(x, w_in, q_norm_g, w_uq, kv_norm_g, w_ukv, w_out, cos, sin):
    b, s, _ = x.shape
    h = x @ w_in
    c_q, c_kv, k_rope, sb_qkv = jnp.split(h, [Q_LORA, Q_LORA + KV_LORA, IN_A], axis=-1)
    q = (rms_norm(c_q, q_norm_g) @ w_uq).reshape(b, s, MLA_HEADS, MLA_NOPE + MLA_ROPE).transpose(0, 2, 1, 3)
    q_nope, q_rope = jnp.split(q, [MLA_NOPE], axis=-1)
    q = jnp.concatenate([q_nope, apply_rope(q_rope, cos, sin)], -1)
    kv = (rms_norm(c_kv, kv_norm_g) @ w_ukv).reshape(b, s, MLA_HEADS, MLA_NOPE + MLA_V).transpose(0, 2, 1, 3)
    k_nope, v_a = jnp.split(kv, [MLA_NOPE], axis=-1)
    k_rope = apply_rope(k_rope[:, None], cos, sin)
    k_a = jnp.concatenate([k_nope, jnp.broadcast_to(k_rope, (b, MLA_HEADS, s, MLA_ROPE))], -1)
    o_a = sweep_query_blocks(lambda qb, i: mla_block(qb, i, k_a, v_a), q)
    q_b, k_b, v_b = sb_qkv.reshape(b, s, 3, SB_HEADS, SB_DIM).transpose(2, 0, 3, 1, 4)
    o_b = sweep_query_blocks(lambda qb, i: stick_breaking_block(qb, i, k_b, v_b), q_b)
    return jnp.concatenate([o_a, o_b], -1) @ w_out


def mixer_fox(x, w_in, b_f, w_out):
    b, s, _ = x.shape
    h = x @ w_in
    qkv, f_logit = jnp.split(h, [3 * FOX_HEADS * FOX_DIM], axis=-1)
    q, k, v = qkv.reshape(b, s, 3, FOX_HEADS, FOX_DIM).transpose(2, 0, 3, 1, 4)
    log_f = jax.nn.log_sigmoid((f_logit + b_f).astype(jnp.float32))
    dcum = lax.cumsum(log_f, axis=1).transpose(0, 2, 1)
    o = sweep_query_blocks(lambda qb, i: forgetting_block(qb, i, k, v, dcum), q)
    return o @ w_out


def swiglu(x, w1, w3, w2):
    return (jax.nn.silu(x @ w1) * (x @ w3)) @ w2


def setup_inputs(seed: int = 0) -> dict:
    key = jax.random.key(seed)
    ks = iter(jax.random.split(key, 32))

    def dense(shape, fan_in, scale=1.0):
        return jax.random.normal(next(ks), shape, jnp.float32) * (fan_in ** -0.5) * scale

    def gain(shape):
        return 1.0 + 0.02 * jax.random.normal(next(ks), shape, jnp.float32)

    def bias(shape):
        return 0.02 * jax.random.normal(next(ks), shape, jnp.float32)

    return {
        "x": jax.random.normal(next(ks), (BATCH, SEQ, D_MODEL), jnp.float32),
        "p": jax.random.normal(next(ks), (DEPTH, BATCH, SEQ, P_DIM), jnp.float32),
        "a_w_in": dense((N_EVEN, D_MODEL, IN_A + IN_B), D_MODEL),
        "a_q_norm": gain((N_EVEN, Q_LORA)),
        "a_w_uq": dense((N_EVEN, Q_LORA, MLA_HEADS * (MLA_NOPE + MLA_ROPE)), Q_LORA),
        "a_kv_norm": gain((N_EVEN, KV_LORA)),
        "a_w_ukv": dense((N_EVEN, KV_LORA, MLA_HEADS * (MLA_NOPE + MLA_V)), KV_LORA),
        "a_w_out": dense((N_EVEN, MIX_A, D_MODEL), MIX_A, DEEPNORM_BETA),
        "c_w_in": dense((N_ODD, D_MODEL, IN_C), D_MODEL),
        "c_b_f": jax.random.uniform(next(ks), (N_ODD, FOX_HEADS), jnp.float32, 1.0, 4.0),
        "c_w_out": dense((N_ODD, MIX_C, D_MODEL), MIX_C, DEEPNORM_BETA),
        "ffn_w1": dense((DEPTH, D_MODEL, D_FF), D_MODEL),
        "ffn_w3": dense((DEPTH, D_MODEL, D_FF), D_MODEL),
        "ffn_w2": dense((DEPTH, D_FF, D_MODEL), D_FF, DEEPNORM_BETA),
        "ln1_g": gain((DEPTH, D_MODEL)),
        "ln1_b": bias((DEPTH, D_MODEL)),
        "ln2_g": gain((DEPTH, D_MODEL)),
        "ln2_b": bias((DEPTH, D_MODEL)),
        "ple_w_proj": dense((DEPTH, P_DIM, D_MODEL), P_DIM),
        "ple_w_gate": dense((DEPTH, D_MODEL, D_MODEL), D_MODEL),
        "ple_b_gate": bias((DEPTH, D_MODEL)),
    }


def reference(x, p, a_w_in, a_q_norm, a_w_uq, a_kv_norm, a_w_ukv, a_w_out,
              c_w_in, c_b_f, c_w_out, ffn_w1, ffn_w3, ffn_w2,
              ln1_g, ln1_b, ln2_g, ln2_b, ple_w_proj, ple_w_gate, ple_b_gate):
    cos, sin = rope_tables(x.shape[1], MLA_ROPE)
    for i in range(DEPTH):
        j = i // 2
        if i % 2 == 0:
            mix = mixer_mla_sb(x, a_w_in[j], a_q_norm[j], a_w_uq[j], a_kv_norm[j],
                               a_w_ukv[j], a_w_out[j], cos, sin)
        else:
            mix = mixer_fox(x, c_w_in[j], c_b_f[j], c_w_out[j])
        x = layer_norm(DEEPNORM_ALPHA * x + mix, ln1_g[i], ln1_b[i])
        x = layer_norm(DEEPNORM_ALPHA * x + swiglu(x, ffn_w1[i], ffn_w3[i], ffn_w2[i]), ln2_g[i], ln2_b[i])
        x = x + jax.nn.sigmoid(x @ ple_w_gate[i] + ple_b_gate[i]) * (p[i] @ ple_w_proj[i])
    return x
```

```cpp
#include <hip/hip_runtime.h>
#include <hip/hip_cooperative_groups.h>
#include <cstdio>
#include <cstdint>
#include <type_traits>
namespace cg = cooperative_groups;

#define LAS __attribute__((address_space(3)))
typedef _Float16 h16;
typedef _Float16 h16x2 __attribute__((ext_vector_type(2)));
typedef _Float16 h16x4 __attribute__((ext_vector_type(4)));
typedef _Float16 h16x8 __attribute__((ext_vector_type(8)));
typedef float f32x2 __attribute__((ext_vector_type(2)));
typedef float f32x4 __attribute__((ext_vector_type(4)));
typedef float f32x16 __attribute__((ext_vector_type(16)));
typedef unsigned u32x2 __attribute__((ext_vector_type(2)));
typedef unsigned u32x4 __attribute__((ext_vector_type(4)));

#ifndef MK_ONE_LAUNCH
#define MK_ONE_LAUNCH 1
#endif

constexpr int SEQ = 4096, NB = 8, T = NB * SEQ, DM = 1024, DFF = 2816, PD = 256;
constexpr int NIN_A = 2304;
constexpr int NIN_C = 3328;
constexpr float ALPHA = 1.41421356237309515f;
constexpr float LOG2E = 1.44269504088896341f;
constexpr float QS_MLA = 0.10206207261596575f * LOG2E;
constexpr float QS_64 = 0.125f * LOG2E;
constexpr int NPHASE = 18;
#ifndef PH_MASK
#define PH_MASK 0xFFFFF
#endif
#define PH_EN(k) ((PH_MASK >> (k)) & 1)

constexpr size_t MiB = 1u << 20;
constexpr size_t WS_SSQ = 0;
constexpr size_t WS_BAR = 384 * 1024;
constexpr size_t WS_ROPE = 512 * 1024;
constexpr size_t WS_WINA = 1 * MiB;
constexpr size_t WS_WUQ = WS_WINA + (size_t)NIN_A * 1024 * 2;
constexpr size_t WS_WUKV = WS_WUQ + 768 * 256 * 2;
constexpr size_t WS_WOUTA = WS_WUKV + 1024 * 256 * 2;
constexpr size_t WS_WINC = WS_WOUTA + 1024 * 1024 * 2;
constexpr size_t WS_WOUTC = WS_WINC + (size_t)NIN_C * 1024 * 2;
constexpr size_t WS_W13 = WS_WOUTC + 1024 * 1024 * 2;
constexpr size_t WS_W2 = WS_W13 + (size_t)2 * 5632 * 1024 * 2;
constexpr size_t WS_WG = WS_W2 + (size_t)2 * 1024 * 2816 * 2;
constexpr size_t WS_WP = WS_WG + (size_t)2 * 1024 * 1024 * 2;
constexpr size_t WS_WEND = WS_WP + (size_t)2 * 1024 * 256 * 2;
static_assert(WS_WEND <= 62 * MiB, "weights region");
constexpr size_t WS_STATS = 56 * MiB;
constexpr size_t WS_CVEC = 57 * MiB;
constexpr size_t WS_ZERO_BYTES = 1 * MiB + 128 * 1024;
constexpr int CV_N = 6656;
static_assert(WS_WEND <= WS_STATS, "weights vs stats");
constexpr size_t WS_FLT = 62 * MiB;
constexpr size_t WS_PB = 64 * MiB;
constexpr size_t WS_XBA = 96 * MiB;
constexpr size_t WS_R1 = 160 * MiB;
constexpr size_t WS_U = WS_R1;
constexpr size_t WS_XBB = WS_R1;
constexpr size_t WS_XF = WS_R1 + 176 * MiB;
constexpr size_t WS_CQ = WS_R1, WS_CKV = WS_R1 + 16 * MiB, WS_QA = WS_R1 + 32 * MiB, WS_KA = WS_R1 + 80 * MiB, WS_VAT = WS_R1 + 128 * MiB;
constexpr size_t WS_QB = WS_R1 + 160 * MiB, WS_KB = WS_R1 + 192 * MiB, WS_VBT = WS_R1 + 224 * MiB, WS_OCAT = WS_R1 + 256 * MiB;
constexpr size_t WS_Q1 = WS_R1 + 64 * MiB, WS_K1 = WS_R1 + 128 * MiB, WS_VT1 = WS_R1 + 192 * MiB;
constexpr size_t WS_END = WS_R1 + 320 * MiB;

constexpr int LDS_BYTES = 131072 + 1024;

__device__ __forceinline__ int lane_id_opaque() { unsigned z = 0u; asm volatile("" : "+v"(z)); return (int)__builtin_amdgcn_mbcnt_hi(~0u, __builtin_amdgcn_mbcnt_lo(~0u, z)); }
namespace pg8 {
constexpr int BM = 256, BK = 64, HALF = 128, HTB = HALF * BK * 2, NXCD = 8, WGM = 8;
__host__ __device__ __forceinline__ int lds_byte(int r, int c) { const int st = (r >> 4) * 2 + (c >> 5), rr = r & 15, cc = c & 31, ob = rr * 64 + cc * 2; return st * 1024 + (ob ^ (((ob >> 9) & 1) << 5)); }
__host__ __device__ __forceinline__ void stage_rc(int b, int& R, int& C) { const int st = b / 1024, sb = b % 1024, swz = sb ^ (((sb >> 9) & 1) << 5); R = (st >> 1) * 16 + swz / 64; C = (st & 1) * 32 + (swz % 64) / 2; }
__host__ __device__ __forceinline__ int perm32(int rho) { const int n = rho >> 4, i = rho & 15; return 8 * (i >> 2) + 4 * n + (i & 3); }

struct Unit { int pm, pn; };
struct Gemm { const h16* A; const h16* Bt; int M, N, K; };

struct StaticOrder {
    int nM, nN, nwg, G, c;
    __device__ void init(int M, int N, int G_, int c_) { nM = M / BM; nN = N / BM; nwg = nM * nN; G = G_; c = c_; }
    __device__ bool next(int i, Unit& u) const {
        const long L = (long)i * G + c; if (L >= nwg) return false;
        int wgid = (int)L; { const int q = nwg / NXCD, r = nwg % NXCD, xcd = wgid % NXCD, off = wgid / NXCD; wgid = (xcd < r ? xcd * (q + 1) : r * (q + 1) + (xcd - r) * q) + off; }
        const int nig = WGM * nN, gid = wgid / nig, fm = gid * WGM, gsz = (nM - fm) < WGM ? (nM - fm) : WGM;
        u.pm = fm + ((wgid % nig) % gsz); u.pn = (wgid % nig) / gsz; return true;
    }
};

template <class Epi, class Sched, bool ALIGN_EPI = true, bool SP2 = true>
__device__ __forceinline__ void gemm_phase(LAS unsigned char* lds, const Gemm g, const Sched& S, const Epi& E, int wave_id) {
    int lane_ = lane_id_opaque(); asm volatile("" : "+v"(lane_));
    const int wid = wave_id, lane = lane_, tid = wid * 64 + lane, wr = wid >> 2, wc = wid & 3, fr = lane & 15, fq = lane >> 4;
    const int K = g.K, nt = K / BK;
    unsigned voffA[2], voffB[2];
#pragma unroll
    for (int i = 0; i < 2; ++i) { int R, C; stage_rc(tid * 16 + i * 8192, R, C); const int Rb = Epi::PERM ? ((R & ~31) + perm32(R & 31)) : R;
        voffA[i] = (unsigned)(R * K + C) * 2u; voffB[i] = (unsigned)(Rb * K + C) * 2u; }
    const size_t kstep = (size_t)(BK * 2);
    const size_t hstep = (size_t)HALF * K * 2;
    const size_t tstep = 2 * hstep;
    const unsigned ldsw = (unsigned)wid * 1024u;
    const int aoff = lds_byte(wr * 64 + fr, fq * 8), boff = lds_byte(wc * 32 + fr, fq * 8);
#define PG8_SA(b, h) (((b) * 2 + (h)) * HTB)
#define PG8_SB(b, h) ((4 + (b) * 2 + (h)) * HTB)
#define PG8_STAGE(bufoff, gbase, voff) do { _Pragma("unroll") for (int _i = 0; _i < 2; ++_i) \
        __builtin_amdgcn_global_load_lds((const unsigned*)((const char*)(gbase) + (voff)[_i]), (LAS unsigned*)(lds + (bufoff) + ldsw + _i * 8192), 16, 0, 0); } while (0)
#define PG8_LDA(dst, b, h) do { _Pragma("unroll") for (int m = 0; m < 4; ++m) _Pragma("unroll") for (int k = 0; k < 2; ++k) dst[m][k] = *(const LAS h16x8*)(lds + PG8_SA(b, h) + aoff + m * 2048 + k * 1024); } while (0)
#define PG8_LDB(dst, b, h) do { _Pragma("unroll") for (int n = 0; n < 2; ++n) _Pragma("unroll") for (int k = 0; k < 2; ++k) dst[n][k] = *(const LAS h16x8*)(lds + PG8_SB(b, h) + boff + n * 2048 + k * 1024); } while (0)
#define PG8_MMA(ai, bj, At, Bt) do { __builtin_amdgcn_s_setprio(1); _Pragma("unroll") for (int m = 0; m < 4; ++m) _Pragma("unroll") for (int n = 0; n < 2; ++n) _Pragma("unroll") for (int k = 0; k < 2; ++k) \
        acc[ai][bj][m][n] = __builtin_amdgcn_mfma_f32_16x16x32_f16(Bt[n][k], At[m][k], acc[ai][bj][m][n], 0, 0, 0); __builtin_amdgcn_s_setprio(0); } while (0)
#define PG8_WAIT_V(n) asm volatile("s_waitcnt vmcnt(" #n ")" ::: "memory")
#define PG8_WAIT_L(n) asm volatile("s_waitcnt lgkmcnt(" #n ")" ::: "memory")
#define PG8_BAR __builtin_amdgcn_s_barrier()
#define PG8_SCHED __builtin_amdgcn_sched_barrier(0)
    Unit cur, nxt; int ui = 0;
    if (!S.next(0, cur)) return;
    f32x4 acc[2][2][4][2];
#pragma unroll
    for (int a = 0; a < 2; ++a)
#pragma unroll
        for (int b = 0; b < 2; ++b)
#pragma unroll
            for (int m = 0; m < 4; ++m)
#pragma unroll
                for (int n = 0; n < 2; ++n) acc[a][b][m][n] = (f32x4){0.f, 0.f, 0.f, 0.f};
    h16x8 At[4][2], B0[2][2], B1[2][2];
    const char* cA = (const char*)g.A + (size_t)cur.pm * tstep; const char* cB = (const char*)g.Bt + (size_t)cur.pn * tstep;
    if constexpr (SP2) {
        PG8_STAGE(PG8_SB(0, 0), cB, voffB); PG8_STAGE(PG8_SB(0, 1), cB + hstep, voffB); PG8_STAGE(PG8_SA(0, 0), cA, voffA); PG8_STAGE(PG8_SA(0, 1), cA + hstep, voffA);
        if (wr == 1) PG8_BAR;
        PG8_WAIT_V(2); PG8_BAR;
        PG8_STAGE(PG8_SB(1, 0), cB + kstep, voffB); PG8_STAGE(PG8_SA(1, 0), cA + kstep, voffA); PG8_STAGE(PG8_SB(1, 1), cB + hstep + kstep, voffB);
        PG8_WAIT_V(6); PG8_BAR;
    } else {
        PG8_STAGE(PG8_SB(0, 0), cB, voffB); PG8_STAGE(PG8_SA(0, 0), cA, voffA); PG8_STAGE(PG8_SB(0, 1), cB + hstep, voffB); PG8_STAGE(PG8_SA(0, 1), cA + hstep, voffA);
        if (wr == 1) PG8_BAR;
        PG8_WAIT_V(4); PG8_BAR;
        PG8_STAGE(PG8_SB(1, 0), cB + kstep, voffB); PG8_STAGE(PG8_SA(1, 0), cA + kstep, voffA); PG8_STAGE(PG8_SB(1, 1), cB + hstep + kstep, voffB);
        PG8_WAIT_V(6); PG8_BAR;
    }
    for (;;) {
        const bool has_next = S.next(ui + 1, nxt);
        const char* nA = has_next ? (const char*)g.A + (size_t)nxt.pm * tstep : cA; const char* nB = has_next ? (const char*)g.Bt + (size_t)nxt.pn * tstep : cB;
        for (int t = 0; t < nt; t += 2) {
            const bool last = (t == nt - 2);
            const char* a1 = cA + (size_t)(t + 1) * kstep;
            const char* a2 = last ? nA : cA + (size_t)(t + 2) * kstep; const char* b2 = last ? nB : cB + (size_t)(t + 2) * kstep;
            const char* a3 = a2 + kstep; const char* b3 = b2 + kstep;
            if constexpr (SP2) {
            PG8_LDB(B0, 0, 0); PG8_LDB(B1, 0, 1); PG8_SCHED; PG8_LDA(At, 0, 0); PG8_STAGE(PG8_SA(1, 1), a1 + hstep, voffA);
            PG8_WAIT_V(8); PG8_WAIT_L(0); PG8_BAR; PG8_MMA(0, 0, At, B0); PG8_MMA(0, 1, At, B1); PG8_BAR; PG8_SCHED;
            PG8_LDA(At, 0, 1); PG8_STAGE(PG8_SB(0, 0), b2, voffB); PG8_STAGE(PG8_SB(0, 1), b2 + hstep, voffB); PG8_STAGE(PG8_SA(0, 0), a2, voffA);
            PG8_WAIT_V(8); PG8_WAIT_L(0); PG8_BAR; PG8_MMA(1, 0, At, B0); PG8_MMA(1, 1, At, B1); PG8_BAR; PG8_SCHED;
            PG8_LDB(B0, 1, 0); PG8_LDB(B1, 1, 1); PG8_SCHED; PG8_LDA(At, 1, 0); PG8_STAGE(PG8_SA(0, 1), a2 + hstep, voffA);
            PG8_WAIT_V(8); PG8_WAIT_L(0); PG8_BAR; PG8_MMA(0, 0, At, B0); PG8_MMA(0, 1, At, B1); PG8_BAR; PG8_SCHED;
            PG8_LDA(At, 1, 1); PG8_STAGE(PG8_SB(1, 0), b3, voffB); PG8_STAGE(PG8_SB(1, 1), b3 + hstep, voffB); PG8_STAGE(PG8_SA(1, 0), a3, voffA);
            PG8_WAIT_V(8); PG8_WAIT_L(0); PG8_BAR; PG8_MMA(1, 0, At, B0); PG8_MMA(1, 1, At, B1); PG8_BAR; PG8_SCHED;
            } else {
            PG8_LDB(B0, 0, 0); PG8_SCHED; PG8_LDA(At, 0, 0); PG8_STAGE(PG8_SA(1, 1), a1 + hstep, voffA);
            PG8_WAIT_L(8); PG8_BAR; PG8_WAIT_L(0); PG8_MMA(0, 0, At, B0); PG8_BAR; PG8_SCHED;
            PG8_LDB(B1, 0, 1); PG8_STAGE(PG8_SB(0, 0), b2, voffB);
            PG8_BAR; PG8_WAIT_L(0); PG8_MMA(0, 1, At, B1); PG8_BAR;
            PG8_LDA(At, 0, 1); PG8_STAGE(PG8_SA(0, 0), a2, voffA);
            PG8_BAR; PG8_WAIT_L(0); PG8_MMA(1, 0, At, B0); PG8_BAR; PG8_SCHED;
            PG8_STAGE(PG8_SB(0, 1), b2 + hstep, voffB);
            PG8_WAIT_V(6); PG8_BAR; PG8_MMA(1, 1, At, B1); PG8_BAR;
            PG8_LDB(B0, 1, 0); PG8_SCHED; PG8_LDA(At, 1, 0); PG8_STAGE(PG8_SA(0, 1), a2 + hstep, voffA);
            PG8_WAIT_L(8); PG8_BAR; PG8_WAIT_L(0); PG8_MMA(0, 0, At, B0); PG8_BAR; PG8_SCHED;
            PG8_LDB(B1, 1, 1); PG8_STAGE(PG8_SB(1, 0), b3, voffB);
            PG8_BAR; PG8_WAIT_L(0); PG8_MMA(0, 1, At, B1); PG8_BAR;
            PG8_LDA(At, 1, 1); PG8_STAGE(PG8_SA(1, 0), a3, voffA);
            PG8_BAR; PG8_WAIT_L(0); PG8_MMA(1, 0, At, B0); PG8_BAR; PG8_SCHED;
            PG8_STAGE(PG8_SB(1, 1), b3 + hstep, voffB);
            PG8_WAIT_V(6); PG8_BAR; PG8_MMA(1, 1, At, B1); PG8_BAR;
            }
        }
        if constexpr (ALIGN_EPI) { if (wr == 0) PG8_BAR; }
        { const int ln_ = lane_id_opaque(); int fr_ = ln_ & 15, fq_ = ln_ >> 4; asm volatile("" : "+v"(fr_), "+v"(fq_));
          E(acc, cur, wr, wc, fr_, fq_); }
        if (!has_next) break;
#pragma unroll
        for (int a = 0; a < 2; ++a)
#pragma unroll
            for (int b = 0; b < 2; ++b)
#pragma unroll
                for (int m = 0; m < 4; ++m)
#pragma unroll
                    for (int n = 0; n < 2; ++n) acc[a][b][m][n] = (f32x4){0.f, 0.f, 0.f, 0.f};
        cur = nxt; cA = nA; cB = nB; ++ui;
        if constexpr (ALIGN_EPI) { if (wr == 1) PG8_BAR; }
    }
    PG8_WAIT_V(0);
    if constexpr (!ALIGN_EPI) { if (wr == 0) PG8_BAR; }
    PG8_BAR;
#undef PG8_SA
#undef PG8_SB
#undef PG8_STAGE
#undef PG8_LDA
#undef PG8_LDB
#undef PG8_MMA
#undef PG8_WAIT_V
#undef PG8_WAIT_L
#undef PG8_BAR
#undef PG8_SCHED
}
}

typedef float acc_t[2][2][4][2][4];
using pg8::Unit;
#define ACC_ARG const f32x4 (&acc)[2][2][4][2]

__device__ __forceinline__ float shx(float x, int mask, int lane) { return __builtin_bit_cast(float, __builtin_amdgcn_ds_bpermute((lane ^ mask) << 2, __builtin_bit_cast(int, x))); }
__device__ __forceinline__ float shup(float x, int off, int lane) { return __builtin_bit_cast(float, __builtin_amdgcn_ds_bpermute((lane - off) << 2, __builtin_bit_cast(int, x))); }
__device__ __forceinline__ unsigned pk2(float a, float b) { h16x2 v; v.x = (h16)a; v.y = (h16)b; return __builtin_bit_cast(unsigned, v); }
__device__ __forceinline__ u32x2 pk4(f32x4 v) { u32x2 r; r.x = pk2(v[0], v[1]); r.y = pk2(v[2], v[3]); return r; }
__device__ __forceinline__ unsigned pk2z(float a, float b) { return __builtin_bit_cast(unsigned, __builtin_amdgcn_cvt_pkrtz(a, b)); }

struct EpiInA {
    static constexpr bool PERM = false;
    h16 *QB, *KB, *VBT, *CQ, *CKV, *KA; float* SSQ; const float* ROPE;
    __device__ __forceinline__ void operator()(ACC_ARG, const Unit& u, int wr, int wc, int fr, int fq) const {
        const int pn = u.pn;
        if (pn == 8 && wc != 0) return;
#pragma unroll
        for (int ai = 0; ai < 2; ++ai)
#pragma unroll
            for (int m = 0; m < 4; ++m) {
                const int row = u.pm * 256 + ai * 128 + wr * 64 + m * 16 + fr, b = row >> 12, s = row & 4095;
                if (pn < 6) {
#pragma unroll
                    for (int bj = 0; bj < 2; ++bj)
#pragma unroll
                        for (int n = 0; n < 2; ++n) {
                            const int c = (pn & 1) * 256 + bj * 128 + wc * 32 + n * 16 + fq * 4, head = c >> 6, d = c & 63;
                            f32x4 v = acc[ai][bj][m][n];
                            if (pn < 2) { v = v * QS_64; *(u32x2*)(QB + ((size_t)(b * 8 + head) * SEQ + s) * 64 + d) = pk4(v); }
                            else if (pn < 4) { *(u32x2*)(KB + ((size_t)(b * 8 + head) * SEQ + s) * 64 + d) = pk4(v); }
                            else { h16* vp = VBT + ((size_t)(b * 8 + head) * 64 + (s >> 6)) * 4096 + (size_t)d * 64 + (s & 63);
#pragma unroll
                                for (int e = 0; e < 4; ++e) vp[e * 64] = (h16)v[e]; }
                        }
                } else if (pn < 8) {
                    h16* dst = (pn == 6 ? CQ : CKV) + (size_t)row * 256;
                    float ss = 0.f;
#pragma unroll
                    for (int bj = 0; bj < 2; ++bj)
#pragma unroll
                        for (int n = 0; n < 2; ++n) {
                            const f32x4 v = acc[ai][bj][m][n];
                            ss += (v[0] * v[0] + v[1] * v[1]) + (v[2] * v[2] + v[3] * v[3]);
                            *(u32x2*)(dst + bj * 128 + wc * 32 + n * 16 + fq * 4) = pk4(v);
                        }
                    { const int ln = fr + 16 * fq; ss += shx(ss, 16, ln); ss += shx(ss, 32, ln); }
                    if (fq == 0) atomicAdd(SSQ + (size_t)row * 2 + (pn - 6), ss);
                } else {
                    const f32x4 x1 = acc[ai][0][m][0], x2 = acc[ai][0][m][1];
                    const float* rp = ROPE + ((size_t)s * 16 + fq * 4) * 2;
                    const f32x4 cs0 = *(const f32x4*)rp, cs1 = *(const f32x4*)(rp + 4);
                    f32x4 o1, o2;
                    o1[0] = x1[0] * cs0[0] - x2[0] * cs0[1]; o2[0] = x1[0] * cs0[1] + x2[0] * cs0[0];
                    o1[1] = x1[1] * cs0[2] - x2[1] * cs0[3]; o2[1] = x1[1] * cs0[3] + x2[1] * cs0[2];
                    o1[2] = x1[2] * cs1[0] - x2[2] * cs1[1]; o2[2] = x1[2] * cs1[1] + x2[2] * cs1[0];
                    o1[3] = x1[3] * cs1[2] - x2[3] * cs1[3]; o2[3] = x1[3] * cs1[3] + x2[3] * cs1[2];
                    const u32x2 p1 = pk4(o1), p2 = pk4(o2);
#pragma unroll
                    for (int h = 0; h < 8; ++h) { h16* kp = KA + ((size_t)(b * 8 + h) * SEQ + s) * 96 + 64 + fq * 4; *(u32x2*)kp = p1; *(u32x2*)(kp + 16) = p2; }
                }
            }
    }
};

struct EpiUq {
    static constexpr bool PERM = false;
    h16* QA; const float* SSQ; const float* ROPE;
    __device__ __forceinline__ void operator()(ACC_ARG, const Unit& u, int wr, int wc, int fr, int fq) const {
        float ssv[2][4];
#pragma unroll
        for (int ai = 0; ai < 2; ++ai)
#pragma unroll
            for (int m = 0; m < 4; ++m) ssv[ai][m] = SSQ[(size_t)(u.pm * 256 + ai * 128 + wr * 64 + m * 16 + fr) * 2 + 0];
        __builtin_amdgcn_sched_barrier(0);
#pragma unroll
        for (int ai = 0; ai < 2; ++ai)
#pragma unroll
            for (int m = 0; m < 4; ++m) {
                const int row = u.pm * 256 + ai * 128 + wr * 64 + m * 16 + fr, b = row >> 12, s = row & 4095;
                const float rs = __builtin_amdgcn_rsqf(ssv[ai][m] * (1.f / 256.f) + 1e-6f) * QS_MLA;
#pragma unroll
                for (int bj = 0; bj < 2; ++bj) {
                    const int g32 = u.pn * 8 + bj * 4 + wc, head = g32 / 3, part = g32 - head * 3;
                    h16* qp = QA + ((size_t)(b * 8 + head) * SEQ + s) * 96;
                    if (part < 2) {
#pragma unroll
                        for (int n = 0; n < 2; ++n) *(u32x2*)(qp + part * 32 + n * 16 + fq * 4) = pk4(acc[ai][bj][m][n] * rs);
                    } else {
                        const f32x4 x1 = acc[ai][bj][m][0] * rs, x2 = acc[ai][bj][m][1] * rs;
                        const float* rp = ROPE + ((size_t)s * 16 + fq * 4) * 2;
                        const f32x4 cs0 = *(const f32x4*)rp, cs1 = *(const f32x4*)(rp + 4);
                        f32x4 o1, o2;
                        o1[0] = x1[0] * cs0[0] - x2[0] * cs0[1]; o2[0] = x1[0] * cs0[1] + x2[0] * cs0[0];
                        o1[1] = x1[1] * cs0[2] - x2[1] * cs0[3]; o2[1] = x1[1] * cs0[3] + x2[1] * cs0[2];
                        o1[2] = x1[2] * cs1[0] - x2[2] * cs1[1]; o2[2] = x1[2] * cs1[1] + x2[2] * cs1[0];
                        o1[3] = x1[3] * cs1[2] - x2[3] * cs1[3]; o2[3] = x1[3] * cs1[3] + x2[3] * cs1[2];
                        *(u32x2*)(qp + 64 + fq * 4) = pk4(o1); *(u32x2*)(qp + 80 + fq * 4) = pk4(o2);
                    }
                }
            }
    }
};

struct EpiUkv {
    static constexpr bool PERM = false;
    h16 *KA, *VAT; const float* SSQ;
    __device__ __forceinline__ void operator()(ACC_ARG, const Unit& u, int wr, int wc, int fr, int fq) const {
        float ssv[2][4];
#pragma unroll
        for (int ai = 0; ai < 2; ++ai)
#pragma unroll
            for (int m = 0; m < 4; ++m) ssv[ai][m] = SSQ[(size_t)(u.pm * 256 + ai * 128 + wr * 64 + m * 16 + fr) * 2 + 1];
        __builtin_amdgcn_sched_barrier(0);
#pragma unroll
        for (int ai = 0; ai < 2; ++ai)
#pragma unroll
            for (int m = 0; m < 4; ++m) {
                const int row = u.pm * 256 + ai * 128 + wr * 64 + m * 16 + fr, b = row >> 12, s = row & 4095;
                const float rs = __builtin_amdgcn_rsqf(ssv[ai][m] * (1.f / 256.f) + 1e-6f);
#pragma unroll
                for (int bj = 0; bj < 2; ++bj) {
                    const int head = u.pn * 2 + bj;
#pragma unroll
                    for (int n = 0; n < 2; ++n) {
                        const f32x4 v = acc[ai][bj][m][n] * rs;
                        const int e128 = wc * 32 + n * 16 + fq * 4;
                        if (wc < 2) *(u32x2*)(KA + ((size_t)(b * 8 + head) * SEQ + s) * 96 + e128) = pk4(v);
                        else { h16* vp = VAT + ((size_t)(b * 8 + head) * 64 + (s >> 6)) * 4096 + (size_t)(e128 - 64) * 64 + (s & 63);
#pragma unroll
                            for (int e = 0; e < 4; ++e) vp[e * 64] = (h16)v[e]; }
                    }
                }
            }
    }
};

__device__ __forceinline__ void ln_stats(const float* st, size_t row, float& mu, float& rs) {
    const f32x2 v = *(const f32x2*)(st + row * 2);
    mu = v.x * (1.f / 1024.f);
    const float var = fmaxf(v.y * (1.f / 1024.f) - mu * mu, 0.f);
    rs = __builtin_amdgcn_rsqf(var + 1e-5f);
}
struct EpiResLn {
    static constexpr bool PERM = true; static constexpr bool PREFETCH = false;
    const h16* X; const h16* XS; const float* st_in; const float* g_in; const float* b_in;
    h16* Yh; float* st_out;
    __device__ __forceinline__ void operator()(ACC_ARG, const Unit& u, int wr, int wc, int fr, int fq) const {
        const int ln = fr + 16 * fq;
        const h16* src = X ? X : XS;
        u32x4 xin[2][4]; f32x4 gg[2][2], bb[2][2];
        float sy[4], sq[4], mu[4], rs[4];
        auto loadq = [&](int b, int buf) {
            const int ai = b >> 1, bj = b & 1, col = u.pn * 256 + bj * 128 + wc * 32 + fq * 8;
            const size_t row0 = (size_t)(u.pm * 256 + ai * 128 + wr * 64 + fr);
#pragma unroll
            for (int m = 0; m < 4; ++m) xin[buf][m] = *(const u32x4*)(src + (row0 + 16 * m) * DM + col);
            if (!X) {
#pragma unroll
                for (int n = 0; n < 2; ++n) { gg[buf][n] = *(const f32x4*)(g_in + col + 4 * n); bb[buf][n] = *(const f32x4*)(b_in + col + 4 * n); }
            }
        };
        loadq(0, 0);
#pragma unroll
        for (int b = 0; b < 4; ++b) {
            const int ai = b >> 1, bj = b & 1, buf = b & 1, col = u.pn * 256 + bj * 128 + wc * 32 + fq * 8;
            const size_t row0 = (size_t)(u.pm * 256 + ai * 128 + wr * 64 + fr);
            if (bj == 0) {
#pragma unroll
                for (int m = 0; m < 4; ++m) { sy[m] = 0.f; sq[m] = 0.f; mu[m] = 0.f; rs[m] = 1.f; if (!X) ln_stats(st_in, row0 + 16 * m, mu[m], rs[m]); }
            }
            if (b + 1 < 4) loadq(b + 1, buf ^ 1);
            __builtin_amdgcn_sched_barrier(0);
#pragma unroll
            for (int m = 0; m < 4; ++m) {
                const h16x8 xh = __builtin_bit_cast(h16x8, xin[buf][m]); u32x4 w;
#pragma unroll
                for (int n = 0; n < 2; ++n) {
                    f32x4 x; x[0] = (float)xh[4 * n]; x[1] = (float)xh[4 * n + 1]; x[2] = (float)xh[4 * n + 2]; x[3] = (float)xh[4 * n + 3];
                    if (!X) x = (x - mu[m]) * rs[m] * gg[buf][n] + bb[buf][n];
                    const f32x4 y = x * ALPHA + acc[ai][bj][m][n];
                    sy[m] += (y[0] + y[1]) + (y[2] + y[3]); sq[m] += (y[0] * y[0] + y[1] * y[1]) + (y[2] * y[2] + y[3] * y[3]);
                    const u32x2 p = pk4(y); if (n == 0) { w.x = p.x; w.y = p.y; } else { w.z = p.x; w.w = p.y; }
                }
                *(u32x4*)(Yh + (row0 + 16 * m) * DM + col) = w;
            }
            if (bj == 1) {
#pragma unroll
                for (int m = 0; m < 4; ++m) {
                    float a = sy[m], c = sq[m];
                    a += shx(a, 16, ln); a += shx(a, 32, ln); c += shx(c, 16, ln); c += shx(c, 32, ln);
                    if (fq == 0) { atomicAdd(st_out + (row0 + 16 * m) * 2, a); atomicAdd(st_out + (row0 + 16 * m) * 2 + 1, c); }
                }
            }
        }
    }
};

struct EpiSwiglu {
    static constexpr bool PERM = true;
    h16* U; const float* st; const float* c1; const float* c2;
    __device__ __forceinline__ void operator()(ACC_ARG, const Unit& u, int wr, int wc, int fr, int fq) const {
        f32x4 k1[2][2], k2[2][2];
#pragma unroll
        for (int bj = 0; bj < 2; ++bj)
#pragma unroll
            for (int n = 0; n < 2; ++n) { const int nd = u.pn * 256 + bj * 128 + wc * 32 + fq * 8 + 4 * n; k1[bj][n] = *(const f32x4*)(c1 + nd); k2[bj][n] = *(const f32x4*)(c2 + nd); }
        float mus[2][4], rss[2][4];
#pragma unroll
        for (int ai = 0; ai < 2; ++ai)
#pragma unroll
            for (int m = 0; m < 4; ++m) ln_stats(st, (size_t)(u.pm * 256 + ai * 128 + wr * 64 + m * 16 + fr), mus[ai][m], rss[ai][m]);
#pragma unroll
        for (int ai = 0; ai < 2; ++ai)
#pragma unroll
            for (int m = 0; m < 4; ++m) {
                const size_t row = (size_t)(u.pm * 256 + ai * 128 + wr * 64 + m * 16 + fr);
                const float mu = mus[ai][m], rs = rss[ai][m];
                u32x4 w;
#pragma unroll
                for (int n = 0; n < 2; ++n) {
                    const f32x4 g = (acc[ai][0][m][n] - k1[0][n] * mu) * rs + k2[0][n], up = (acc[ai][1][m][n] - k1[1][n] * mu) * rs + k2[1][n]; f32x4 h;
#pragma unroll
                    for (int e = 0; e < 4; ++e) h[e] = g[e] * __builtin_amdgcn_rcpf(1.f + __builtin_amdgcn_exp2f(-g[e] * LOG2E)) * up[e];
                    const u32x2 p = pk4(h); if (n == 0) { w.x = p.x; w.y = p.y; } else { w.z = p.x; w.w = p.y; }
                }
                *(u32x4*)(U + row * DFF + u.pn * 128 + wc * 32 + fq * 8) = w;
            }
    }
};

struct EpiStoreF32 {
    static constexpr bool PERM = true;
    h16* P;
    __device__ __forceinline__ void operator()(ACC_ARG, const Unit& u, int wr, int wc, int fr, int fq) const {
#pragma unroll
        for (int ai = 0; ai < 2; ++ai)
#pragma unroll
            for (int m = 0; m < 4; ++m) {
                const size_t row = (size_t)(u.pm * 256 + ai * 128 + wr * 64 + m * 16 + fr);
#pragma unroll
                for (int bj = 0; bj < 2; ++bj) {
                    const size_t o = row * DM + u.pn * 256 + bj * 128 + wc * 32 + fq * 8;
                    const u32x2 p0 = pk4(acc[ai][bj][m][0]), p1 = pk4(acc[ai][bj][m][1]); u32x4 w; w.x = p0.x; w.y = p0.y; w.z = p1.x; w.w = p1.y;
                    *(u32x4*)(P + o) = w;
                }
            }
    }
};

struct EpiPle {
    static constexpr bool PERM = true;
    const h16* Y2; const float* st; const float* g2; const float* b2; const float* c1; const float* c2; float* Y; const float* bg; h16* XBo; const h16* PJ;
    __device__ __forceinline__ void operator()(ACC_ARG, const Unit& u, int wr, int wc, int fr, int fq) const {
        float mu[2][4], rs[2][4];
#pragma unroll
        for (int ai = 0; ai < 2; ++ai)
#pragma unroll
            for (int m = 0; m < 4; ++m) ln_stats(st, (size_t)(u.pm * 256 + ai * 128 + wr * 64 + m * 16 + fr), mu[ai][m], rs[ai][m]);
#pragma unroll
        for (int bj = 0; bj < 2; ++bj) {
            const int col = u.pn * 256 + bj * 128 + wc * 32 + fq * 8;
            f32x4 gg[2], b2v[2], k1[2], k2b[2];
#pragma unroll
            for (int n = 0; n < 2; ++n) { gg[n] = *(const f32x4*)(g2 + col + 4 * n); b2v[n] = *(const f32x4*)(b2 + col + 4 * n); k1[n] = *(const f32x4*)(c1 + col + 4 * n);
                                          k2b[n] = *(const f32x4*)(c2 + col + 4 * n) + *(const f32x4*)(bg + col + 4 * n); }
#pragma unroll
            for (int ai = 0; ai < 2; ++ai) {
#pragma unroll
              for (int mh = 0; mh < 2; ++mh) {
                u32x4 pin[4], yin[4];
#pragma unroll
                for (int m = 2 * mh; m < 2 * mh + 2; ++m) { const size_t o = (size_t)(u.pm * 256 + ai * 128 + wr * 64 + m * 16 + fr) * DM + col; pin[m] = *(const u32x4*)(PJ + o); yin[m] = *(const u32x4*)(Y2 + o); }
                __builtin_amdgcn_sched_barrier(0);
#pragma unroll
                for (int m = 2 * mh; m < 2 * mh + 2; ++m) {
                    const size_t o = (size_t)(u.pm * 256 + ai * 128 + wr * 64 + m * 16 + fr) * DM + col;
                    u32x4 w; const h16x8 pj = __builtin_bit_cast(h16x8, pin[m]), yh = __builtin_bit_cast(h16x8, yin[m]);
#pragma unroll
                    for (int n = 0; n < 2; ++n) {
                        f32x4 ys; ys[0] = (float)yh[4 * n]; ys[1] = (float)yh[4 * n + 1]; ys[2] = (float)yh[4 * n + 2]; ys[3] = (float)yh[4 * n + 3];
                        f32x4 pr; pr[0] = (float)pj[4 * n]; pr[1] = (float)pj[4 * n + 1]; pr[2] = (float)pj[4 * n + 2]; pr[3] = (float)pj[4 * n + 3];
                        const f32x4 x = (ys - mu[ai][m]) * rs[ai][m] * gg[n] + b2v[n];
                        const f32x4 z = (acc[ai][bj][m][n] - k1[n] * mu[ai][m]) * rs[ai][m] + k2b[n]; f32x4 r;
#pragma unroll
                        for (int e = 0; e < 4; ++e) r[e] = x[e] + __builtin_amdgcn_rcpf(1.f + __builtin_amdgcn_exp2f(-z[e] * LOG2E)) * pr[e];
                        if (!XBo) *(f32x4*)(Y + o + 4 * n) = r;
                        const u32x2 p = pk4(r); if (n == 0) { w.x = p.x; w.y = p.y; } else { w.z = p.x; w.w = p.y; }
                    }
                    if (XBo) *(u32x4*)(XBo + o) = w;
                }
              }
            }
        }
    }
};

struct EpiInC {
    static constexpr bool PERM = true;
    h16 *Q1, *K1, *VT1; float* FLT; const float* bf;
    __device__ __forceinline__ void operator()(ACC_ARG, const Unit& u, int wr, int wc, int fr, int fq) const {
        const int pn = u.pn;
        if (pn == 12 && (wc != 0 || fq >= 2)) return;
#pragma unroll
        for (int ai = 0; ai < 2; ++ai)
#pragma unroll
            for (int m = 0; m < 4; ++m) {
                const int row = u.pm * 256 + ai * 128 + wr * 64 + m * 16 + fr, b = row >> 12, s = row & 4095;
                if (pn < 12) {
#pragma unroll
                    for (int bj = 0; bj < 2; ++bj) {
                        const int head = (pn & 3) * 4 + bj * 2 + (wc >> 1), d = (wc & 1) * 32 + fq * 8;
                        f32x4 v0 = acc[ai][bj][m][0], v1 = acc[ai][bj][m][1];
                        if (pn < 8) {
                            if (pn < 4) { v0 = v0 * QS_64; v1 = v1 * QS_64; }
                            h16* dst = (pn < 4 ? Q1 : K1) + ((size_t)(b * 16 + head) * SEQ + s) * 64 + d;
                            const u32x2 p0 = pk4(v0), p1 = pk4(v1); u32x4 w; w.x = p0.x; w.y = p0.y; w.z = p1.x; w.w = p1.y;
                            *(u32x4*)dst = w;
                        } else {
                            h16* vp = VT1 + ((size_t)(b * 16 + head) * 64 + (s >> 6)) * 4096 + (size_t)d * 64 + (s & 63);
#pragma unroll
                            for (int e = 0; e < 4; ++e) { vp[e * 64] = (h16)v0[e]; vp[(4 + e) * 64] = (h16)v1[e]; }
                        }
                    }
                } else {
#pragma unroll
                    for (int n = 0; n < 2; ++n)
#pragma unroll
                        for (int e = 0; e < 4; ++e) {
                            const int hd = fq * 8 + n * 4 + e;
                            const float z = (acc[ai][0][m][n][e] + bf[hd]) * LOG2E;
                            const float ls = fminf(z, 0.f) - __builtin_amdgcn_logf(1.f + __builtin_amdgcn_exp2f(-fabsf(z)));
                            FLT[(size_t)(b * 16 + hd) * SEQ + s] = ls;
                        }
                }
            }
    }
};

constexpr int AT_KBYTES = 13312, AT_VOFF = 2 * AT_KBYTES, AT_VBYTES = 9216, AT_DCOFF = AT_VOFF + 2 * AT_VBYTES, AT_WSOFF = AT_DCOFF + 16384;
template <int MODE>
__device__ __forceinline__ void attn_unit(LAS unsigned char* lds, const h16* __restrict__ Qg, const h16* __restrict__ Kg, const h16* __restrict__ VTg,
                                          h16* __restrict__ Og, int ocol, const float* __restrict__ FLTg, int b, int bh, int qb, int wave_id) {
    constexpr int D = (MODE == 0) ? 96 : 64, KRS = (D + 8) * 2, VRS = 144, NDS = D / 16;
    constexpr float THR = 8.0f;
    int lane_ = lane_id_opaque(); asm volatile("" : "+v"(lane_));
    const int lane = lane_, w = wave_id, tid = w * 64 + lane, j = lane & 31, hh = lane >> 5;
    const int q0 = qb * 256, qw = q0 + 32 * w, nkt = 4 * qb + 4, kt_last = qw >> 6;
    const int it0 = nkt - 1 - kt_last;
    const int pij = (j & 0x13) | ((j & 4) << 1) | ((j & 8) >> 1);
    const int tqd = 32 * (w & 1) + j;
    LAS float* DC = (LAS float*)(lds + AT_DCOFF);
    __syncthreads();
    h16x8 qf[NDS];
    { const h16* qrow = Qg + ((size_t)bh * SEQ + qw + j) * D + 8 * hh;
#pragma unroll
      for (int ds = 0; ds < NDS; ++ds) qf[ds] = *(const h16x8*)(qrow + 16 * ds); }
    float dt = 0.f;
    if constexpr (MODE == 2) {
        const float* src = FLTg + (size_t)bh * SEQ + 8 * tid;
        const f32x4 a = *(const f32x4*)src, c = *(const f32x4*)(src + 4);
        float v[8] = {a[0], a[1], a[2], a[3], c[0], c[1], c[2], c[3]};
#pragma unroll
        for (int i = 1; i < 8; ++i) v[i] += v[i - 1];
        float x = v[7];
#pragma unroll
        for (int off = 1; off < 64; off <<= 1) { const float y = shup(x, off, lane); if (lane >= off) x += y; }
        LAS float* WS = (LAS float*)(lds + AT_WSOFF);
        if (lane == 63) WS[w] = x;
        __syncthreads();
        float woff = 0.f;
#pragma unroll
        for (int i = 0; i < 8; ++i) { const float t = WS[i]; if (i < w) woff += t; }
        const float excl = x - v[7] + woff;
#pragma unroll
        for (int i = 0; i < 8; ++i) DC[8 * tid + i] = excl + v[i];
        __syncthreads();
        dt = DC[qw + j];
    }
    const int srow = tid >> 3, sch = tid & 7;
    struct StageRegs { u32x4 k0, k1, v; };
    StageRegs RA, RB;
    const int koff0 = (MODE == 0) ? (tid / 12) * 96 + (tid % 12) * 8 : srow * 64 + sch * 8;
    const int koff1 = (MODE == 0) ? ((tid + 512) / 12) * 96 + ((tid + 512) % 12) * 8 : 0;
    const int voff = srow * 64 + sch * 8;
    auto gloadK = [&](int kt, StageRegs& r) {
        const h16* kbase = Kg + ((size_t)bh * SEQ + (size_t)kt * 64) * D;
        r.k0 = *(const u32x4*)(kbase + koff0);
        if constexpr (MODE == 0) { if (tid < 256) r.k1 = *(const u32x4*)(kbase + koff1); }
    };
    auto gloadV = [&](int kt, StageRegs& r) { const h16* vbase = VTg + ((size_t)bh * 64 + (size_t)kt) * 4096; r.v = *(const u32x4*)(vbase + voff); };
    auto lstoreK = [&](int buf, const StageRegs& r) {
        if constexpr (MODE == 0) {
            const int c0 = tid, r0 = c0 / 12, h0 = c0 - r0 * 12;
            *(LAS u32x4*)(lds + buf * AT_KBYTES + r0 * KRS + h0 * 16) = r.k0;
            if (tid < 256) { const int c1 = tid + 512, r1 = c1 / 12, h1 = c1 - r1 * 12; *(LAS u32x4*)(lds + buf * AT_KBYTES + r1 * KRS + h1 * 16) = r.k1; }
        } else {
            *(LAS u32x4*)(lds + buf * AT_KBYTES + srow * KRS + sch * 16) = r.k0;
        }
    };
    auto lstoreV = [&](int buf, const StageRegs& r) { *(LAS u32x4*)(lds + AT_VOFF + buf * AT_VBYTES + srow * VRS + sch * 16) = r.v; };
    auto lds_barrier = [&]() { asm volatile("s_waitcnt lgkmcnt(0)\n\ts_barrier" ::: "memory"); };
    f32x16 oacc[2];
#pragma unroll
    for (int i = 0; i < 16; ++i) { oacc[0][i] = 0.f; oacc[1][i] = 0.f; }
    float m_run = 0.f, R = (MODE == 1) ? 1.f : 0.f;
    f32x16 lacc;
#pragma unroll
    for (int i = 0; i < 16; ++i) lacc[i] = 0.f;
    h16x8 onesf;
#pragma unroll
    for (int i = 0; i < 8; ++i) onesf[i] = (j == 0) ? (h16)1.0f : (h16)0.0f;
    auto ST = [&](f32x16 (&s)[2], int it, auto diag_c) {
        constexpr bool DIAG = decltype(diag_c)::value;
        const int kt = nkt - 1 - it;
#pragma unroll
        for (int ks = 0; ks < 2; ++ks) {
            if constexpr (MODE == 2) {
                const float base = dt - m_run;
#pragma unroll
                for (int run = 0; run < 2; ++run) {
                    const LAS float* dk = DC + 64 * kt + 32 * ks + 16 * run + 8 * hh;
                    const f32x4 d0 = *(const LAS f32x4*)dk, d1 = *(const LAS f32x4*)(dk + 4);
#pragma unroll
                    for (int e = 0; e < 4; ++e) { s[ks][8 * run + e] = base - d0[e]; s[ks][8 * run + 4 + e] = base - d1[e]; }
                }
            } else {
                const float base = (MODE == 0) ? -m_run : 0.f;
#pragma unroll
                for (int r = 0; r < 16; ++r) s[ks][r] = base;
            }
            if constexpr (DIAG && MODE != 0) {
#pragma unroll
                for (int r = 0; r < 16; ++r) { const int kq = 32 * ks + 16 * (r >> 3) + 8 * hh + (r & 7); if (MODE == 1 ? (kq >= tqd) : (kq > tqd)) s[ks][r] = -1e30f; }
            }
            const LAS unsigned char* kb = lds + (it & 1) * AT_KBYTES + (32 * ks + pij) * KRS + hh * 16;
#pragma unroll
            for (int ds = 0; ds < NDS; ++ds) s[ks] = __builtin_amdgcn_mfma_f32_32x32x16_f16(*(const LAS h16x8*)(kb + ds * 32), qf[ds], s[ks], 0, 0, 0);
        }
    };
    auto BMAX = [&](f32x16 (&s)[2], bool first) {
        if constexpr (MODE != 1) {
            float tmx = fmaxf(s[0][0], s[1][0]);
#pragma unroll
            for (int r = 1; r < 16; ++r) tmx = fmaxf(tmx, fmaxf(s[0][r], s[1][r]));
            tmx = fmaxf(tmx, shx(tmx, 32, lane));
            if (first || __builtin_amdgcn_ballot_w64(tmx > THR) != 0ull) {
                const float delta = (first || tmx > THR) ? tmx : 0.f;
                const float corr = first ? 1.f : __builtin_amdgcn_exp2f(-delta);
                m_run += delta; lacc[0] *= corr;
#pragma unroll
                for (int i = 0; i < 16; ++i) { oacc[0][i] *= corr; oacc[1][i] *= corr; s[0][i] -= delta; s[1][i] -= delta; }
            }
        }
    };
    auto SBRUN = [&](const f32x16& sv, int ks, int run, u32x4 (&pf)[4]) {
        float rb[8];
#pragma unroll
        for (int i = 0; i < 8; ++i) {
            const float e = __builtin_amdgcn_exp2f(sv[8 * run + i]);
            rb[i] = __builtin_amdgcn_rcpf(1.f + e);
        }
        const float p = ((rb[0] * rb[1]) * (rb[2] * rb[3])) * ((rb[4] * rb[5]) * (rb[6] * rb[7]));
        const float pp = shx(p, 32, lane);
        float c = R * (hh == 0 ? pp : 1.f);
        unsigned wd[4];
#pragma unroll
        for (int i = 3; i >= 0; --i) {
            const float ch = c * rb[2 * i + 1], ah = c - ch;
            const float cl = ch * rb[2 * i], al = ch - cl;
            c = cl; wd[i] = pk2z(al, ah);
        }
        u32x4 t; t.x = wd[0]; t.y = wd[1]; t.z = wd[2]; t.w = wd[3]; pf[2 * ks + run] = t;
        R *= p * pp;
    };
    auto CD = [&](f32x16 (&s)[2], int it) {
        u32x4 pf[4];
        if constexpr (MODE == 1) {
#pragma unroll
            for (int ks = 1; ks >= 0; --ks) { SBRUN(s[ks], ks, 1, pf); __builtin_amdgcn_sched_barrier(0); SBRUN(s[ks], ks, 0, pf); __builtin_amdgcn_sched_barrier(0); }
        } else {
#pragma unroll
            for (int ks = 0; ks < 2; ++ks) {
                float p[16];
#pragma unroll
                for (int r = 0; r < 16; ++r) p[r] = __builtin_amdgcn_exp2f(s[ks][r]);
#pragma unroll
                for (int run = 0; run < 2; ++run) { u32x4 t; t.x = pk2z(p[8 * run], p[8 * run + 1]); t.y = pk2z(p[8 * run + 2], p[8 * run + 3]); t.z = pk2z(p[8 * run + 4], p[8 * run + 5]); t.w = pk2z(p[8 * run + 6], p[8 * run + 7]); pf[2 * ks + run] = t; }
            }
        }
#pragma unroll
        for (int st = 0; st < 4; ++st) {
            const h16x8 pb = __builtin_bit_cast(h16x8, pf[st]);
#pragma unroll
            for (int dvt = 0; dvt < 2; ++dvt) {
                const LAS unsigned char* vb = lds + AT_VOFF + (it & 1) * AT_VBYTES + (32 * dvt + j) * VRS + st * 32 + hh * 16;
                oacc[dvt] = __builtin_amdgcn_mfma_f32_32x32x16_f16(*(const LAS h16x8*)vb, pb, oacc[dvt], 0, 0, 0);
            }
            if constexpr (MODE != 1) lacc = __builtin_amdgcn_mfma_f32_32x32x16_f16(onesf, pb, lacc, 0, 0, 0);
        }
    };
    auto FUSED = [&](f32x16 (&sc)[2], f32x16 (&sn)[2], int it) {
        constexpr int NA = 2 * NDS, NCH = NA > 8 ? NA : 8;
        const int ktn = nkt - 2 - it;
#pragma unroll
        for (int ks = 0; ks < 2; ++ks) {
            if constexpr (MODE == 2) {
                const float base = dt - m_run;
#pragma unroll
                for (int run = 0; run < 2; ++run) {
                    const LAS float* dk = DC + 64 * ktn + 32 * ks + 16 * run + 8 * hh;
                    const f32x4 d0 = *(const LAS f32x4*)dk, d1 = *(const LAS f32x4*)(dk + 4);
#pragma unroll
                    for (int e = 0; e < 4; ++e) { sn[ks][8 * run + e] = base - d0[e]; sn[ks][8 * run + 4 + e] = base - d1[e]; }
                }
            } else {
                const float base = (MODE == 0) ? -m_run : 0.f;
#pragma unroll
                for (int r = 0; r < 16; ++r) sn[ks][r] = base;
            }
        }
        const LAS unsigned char* kb = lds + ((it + 1) & 1) * AT_KBYTES + pij * KRS + hh * 16;
        const LAS unsigned char* vb = lds + AT_VOFF + (it & 1) * AT_VBYTES + j * VRS + hh * 16;
        h16x8 kf[NA];
        constexpr int PD = 4;
#pragma unroll
        for (int k = 0; k < PD; ++k) kf[k] = *(const LAS h16x8*)(kb + (k / NDS) * 32 * KRS + (k % NDS) * 32);
        u32x4 pf[4]; float pv[8];
        __builtin_amdgcn_sched_barrier(0);
#pragma unroll
        for (int k = 0; k < NCH; ++k) {
            if (k + PD < NA) kf[k + PD] = *(const LAS h16x8*)(kb + ((k + PD) / NDS) * 32 * KRS + ((k + PD) % NDS) * 32);
#ifdef PROBE_LDS
            if (k + 2 < NA) { const volatile LAS u32x4* dp = (const volatile LAS u32x4*)(kb + ((k + 2) / NDS) * 32 * KRS + ((k + 2) % NDS) * 32); u32x4 dd = *dp; asm volatile("" :: "v"(dd)); }
#endif
            if (k < NA) sn[k / NDS] = __builtin_amdgcn_mfma_f32_32x32x16_f16(kf[k], qf[k % NDS], sn[k / NDS], 0, 0, 0);
            if (k < 8) {
                const int ks = k >> 2;
#pragma unroll
                for (int e = 0; e < 4; ++e) {
                    const int r = 4 * (k & 3) + e;
                    { const float p = __builtin_amdgcn_exp2f(sc[ks][r]); pv[4 * (k & 1) + e] = p; }
#ifdef PROBE_VALU
                    { float zz = sc[ks][r]; asm volatile("" : "+v"(zz)); const float p2 = __builtin_amdgcn_exp2f(zz); float acc2 = p2 + 1.0f; asm volatile("" :: "v"(acc2)); }
#endif
                }
                if constexpr (MODE != 1) { if (k & 1) { u32x4 t; t.x = pk2z(pv[0], pv[1]); t.y = pk2z(pv[2], pv[3]); t.z = pk2z(pv[4], pv[5]); t.w = pk2z(pv[6], pv[7]); pf[k >> 1] = t; } }
            }
            __builtin_amdgcn_sched_barrier(0);
        }
        h16x8 vf[8];
#pragma unroll
        for (int k = 0; k < PD; ++k) vf[k] = *(const LAS h16x8*)(vb + (k & 1) * 32 * VRS + (k >> 1) * 32);
        float tmx = -3e38f;
        __builtin_amdgcn_sched_barrier(0);
#pragma unroll
        for (int k = 0; k < 8; ++k) {
            if (k + PD < 8) vf[k + PD] = *(const LAS h16x8*)(vb + ((k + PD) & 1) * 32 * VRS + ((k + PD) >> 1) * 32);
            oacc[k & 1] = __builtin_amdgcn_mfma_f32_32x32x16_f16(vf[k], __builtin_bit_cast(h16x8, pf[k >> 1]), oacc[k & 1], 0, 0, 0);
            if constexpr (MODE != 1) { if (k & 1) lacc = __builtin_amdgcn_mfma_f32_32x32x16_f16(onesf, __builtin_bit_cast(h16x8, pf[k >> 1]), lacc, 0, 0, 0); }
            if constexpr (MODE != 1) {
                const int ks = k >> 2, r0 = 4 * (k & 3);
                tmx = fmaxf(fmaxf(tmx, sn[ks][r0]), sn[ks][r0 + 1]); tmx = fmaxf(fmaxf(tmx, sn[ks][r0 + 2]), sn[ks][r0 + 3]);
            }
            __builtin_amdgcn_sched_barrier(0);
        }
        if constexpr (MODE != 1) {
            tmx = fmaxf(tmx, shx(tmx, 32, lane));
            if (__builtin_expect(__builtin_amdgcn_ballot_w64(tmx > THR) != 0ull, 0)) {
                const float delta = (tmx > THR) ? tmx : 0.f;
                const float corr = __builtin_amdgcn_exp2f(-delta);
                m_run += delta; lacc[0] *= corr;
#pragma unroll
                for (int i = 0; i < 16; ++i) { oacc[0][i] *= corr; oacc[1][i] *= corr; sn[0][i] -= delta; sn[1][i] -= delta; }
            }
        }
    };
    auto BMAXFIRST = [&](f32x16 (&s)[2]) {
        if constexpr (MODE != 1) {
            float tmx = fmaxf(s[0][0], s[1][0]);
#pragma unroll
            for (int r = 1; r < 16; ++r) tmx = fmaxf(fmaxf(tmx, s[0][r]), s[1][r]);
            tmx = fmaxf(tmx, shx(tmx, 32, lane));
            m_run += tmx;
#pragma unroll
            for (int i = 0; i < 16; ++i) { s[0][i] -= tmx; s[1][i] -= tmx; }
        }
    };
    auto STEP = [&](int it, f32x16 (&sc)[2], f32x16 (&sn)[2], StageRegs& rl, StageRegs& rs) {
        if constexpr (MODE == 1) { gloadK(max(nkt - 2 - it, 0), rs); gloadV(max(nkt - 2 - it, 0), rs); }
        else { gloadK(max(nkt - 4 - it, 0), rl); gloadV(max(nkt - 3 - it, 0), rl); }
        const bool act = it >= it0, actn = (it + 1 < nkt) && (it + 1 >= it0);
        if constexpr (MODE == 1) {
            if (act) { if (it == it0) ST(sc, it, std::true_type{}); else ST(sc, it, std::false_type{}); CD(sc, it); }
        } else if (act && actn) FUSED(sc, sn, it);
        else if (actn) { ST(sn, it + 1, std::true_type{}); BMAXFIRST(sn); }
        if constexpr (MODE == 1) { if (it + 1 < nkt) { lstoreK((it + 1) & 1, rs); lstoreV((it + 1) & 1, rs); } }
        else {
        if (it + 2 < nkt) lstoreK(it & 1, rs);
        if (it + 1 < nkt) lstoreV((it + 1) & 1, rs);
        }
        lds_barrier();
    };
    gloadK(nkt - 1, RA); gloadV(nkt - 1, RA); if constexpr (MODE != 1) gloadK(nkt - 2, RB);
    lstoreK(0, RA); lstoreV(0, RA); if constexpr (MODE != 1) lstoreK(1, RB);
    if constexpr (MODE != 1) { gloadK(nkt - 3, RB); gloadV(nkt - 2, RB); }
    lds_barrier();
    f32x16 sa[2], sb[2];
#pragma unroll
    for (int i = 0; i < 16; ++i) { sa[0][i] = 0.f; sa[1][i] = 0.f; sb[0][i] = 0.f; sb[1][i] = 0.f; }
    if constexpr (MODE != 1) { if (it0 == 0) { ST(sa, 0, std::true_type{}); BMAXFIRST(sa); } }
    lds_barrier();
    for (int it = 0; it < nkt; it += 2) { STEP(it, sa, sb, RA, RB); STEP(it + 1, sb, sa, RB, RA); }
    if constexpr (MODE != 1) CD(sb, nkt - 1);
    float inv = 1.f;
    if constexpr (MODE != 1) { const float l0 = lacc[0], lp = shx(l0, 32, lane); inv = 1.f / (hh ? lp : l0); }
    h16* op = Og + ((size_t)b * SEQ + qw + j) * DM + ocol + 4 * hh;
#pragma unroll
    for (int dvt = 0; dvt < 2; ++dvt)
#pragma unroll
        for (int g = 0; g < 4; ++g) {
            f32x4 v; v[0] = oacc[dvt][4 * g] * inv; v[1] = oacc[dvt][4 * g + 1] * inv; v[2] = oacc[dvt][4 * g + 2] * inv; v[3] = oacc[dvt][4 * g + 3] * inv;
            *(u32x2*)(op + 32 * dvt + 8 * g) = pk4(v);
        }
}

template <class F>
__device__ __forceinline__ void prep_w(LAS unsigned char* lds, h16* dst, int Nd, int K, int Ns, const float* kscale, F colptr, int cid, int G, int tid,
                                       float* c1 = nullptr, float* c2 = nullptr, const float* lnb = nullptr) {
    constexpr int NT = 4;
    const int tn = Nd >> 6, tk = K >> 6, ntiles = tn * tk;
    const int rn = tid & 63, rk = tid >> 6;
    const int wn = tid >> 3, wc = tid & 7;
    const float* dummy = colptr(0);
    for (int t0 = cid; t0 < ntiles; t0 += NT * G) {
        float v[NT][8]; bool nul[NT];
#pragma unroll
        for (int q = 0; q < NT; ++q) {
            const int t = min(t0 + q * G, ntiles - 1);
            const int n0 = (t % tn) << 6, k0 = (t / tn) << 6;
            const float* col = colptr(n0 + rn); nul[q] = (col == nullptr); if (nul[q]) col = dummy;
#pragma unroll
            for (int i = 0; i < 8; ++i) v[q][i] = col[(size_t)(k0 + rk + 8 * i) * Ns];
        }
#pragma unroll
        for (int q = 0; q < NT; ++q) {
            const int t = min(t0 + q * G, ntiles - 1);
            const int k0 = (t / tn) << 6;
            LAS h16* tile = (LAS h16*)lds + q * (64 * 72);
#pragma unroll
            for (int i = 0; i < 8; ++i) { float x = nul[q] ? 0.f : v[q][i]; if (kscale) x *= kscale[k0 + rk + 8 * i]; tile[rn * 72 + rk + 8 * i] = (h16)x; }
        }
        __syncthreads();
#pragma unroll
        for (int q = 0; q < NT; ++q) {
            const int t = t0 + q * G;
            if (t < ntiles) {
                const int n0 = (t % tn) << 6, k0 = (t / tn) << 6;
                LAS h16* tile = (LAS h16*)lds + q * (64 * 72);
                const u32x4 w = *(const LAS u32x4*)(tile + wn * 72 + wc * 8);
                *(u32x4*)(dst + (size_t)(n0 + wn) * K + k0 + wc * 8) = w;
                if (c1) {
                    const h16x8 hv = __builtin_bit_cast(h16x8, w);
                    float a1 = 0.f, a2 = 0.f;
#pragma unroll
                    for (int e = 0; e < 8; ++e) { const int kk = k0 + wc * 8 + e; const float f = (float)hv[e]; a1 += f; a2 += f * (lnb[kk] / kscale[kk]); }
                    const int ln = tid & 63;
                    a1 += shx(a1, 1, ln); a1 += shx(a1, 2, ln); a1 += shx(a1, 4, ln);
                    a2 += shx(a2, 1, ln); a2 += shx(a2, 2, ln); a2 += shx(a2, 4, ln);
                    if (wc == 0) { atomicAdd(c1 + n0 + wn, a1); atomicAdd(c2 + n0 + wn, a2); }
                }
            }
        }
        __syncthreads();
    }
}
__device__ __forceinline__ void cvt_rows(h16* dst, const float* src, size_t n8, int gtid, int gthreads) {
    size_t i = gtid;
    for (; i + 3 * (size_t)gthreads < n8; i += 4 * (size_t)gthreads) {
        f32x4 a[4], c[4];
#pragma unroll
        for (int q = 0; q < 4; ++q) { const size_t k = i + (size_t)q * gthreads; a[q] = __builtin_nontemporal_load((const f32x4*)(src + k * 8)); c[q] = __builtin_nontemporal_load((const f32x4*)(src + k * 8 + 4)); }
#pragma unroll
        for (int q = 0; q < 4; ++q) { const size_t k = i + (size_t)q * gthreads;
            u32x4 w; w.x = pk2(a[q][0], a[q][1]); w.y = pk2(a[q][2], a[q][3]); w.z = pk2(c[q][0], c[q][1]); w.w = pk2(c[q][2], c[q][3]);
            *(u32x4*)(dst + k * 8) = w; }
    }
    for (; i < n8; i += gthreads) {
        const f32x4 a = *(const f32x4*)(src + i * 8), c = *(const f32x4*)(src + i * 8 + 4);
        u32x4 w; w.x = pk2(a[0], a[1]); w.y = pk2(a[2], a[3]); w.z = pk2(c[0], c[1]); w.w = pk2(c[2], c[3]);
        *(u32x4*)(dst + i * 8) = w;
    }
}
__device__ __forceinline__ void sincos_d(double r, double& s, double& c) {
    const double r2 = r * r; double ts = r, tc = 1.0; s = r; c = 1.0;
#pragma unroll 1
    for (int n = 1; n <= 14; ++n) { tc *= -r2 / (double)((2 * n - 1) * (2 * n)); c += tc; ts *= -r2 / (double)((2 * n) * (2 * n + 1)); s += ts; }
}

__device__ __forceinline__ void ln_phase(const float* __restrict__ Y, float* __restrict__ XF, h16* __restrict__ XB, const float* __restrict__ g, const float* __restrict__ bt, int wave_id) {
    int lane_ = lane_id_opaque(); asm volatile("" : "+v"(lane_));
    const int lane = lane_, wg = blockIdx.x * 8 + wave_id, nw = gridDim.x * 8;
    f32x4 gv[4], bv[4];
#pragma unroll
    for (int i = 0; i < 4; ++i) { gv[i] = *(const f32x4*)(g + (i * 64 + lane) * 4); bv[i] = *(const f32x4*)(bt + (i * 64 + lane) * 4); }
    for (int row = wg; row < T; row += nw) {
        const float* y = Y + (size_t)row * DM; f32x4 v[4]; float s = 0.f;
#pragma unroll
        for (int i = 0; i < 4; ++i) { v[i] = *(const f32x4*)(y + (i * 64 + lane) * 4); s += (v[i][0] + v[i][1]) + (v[i][2] + v[i][3]); }
#pragma unroll
        for (int off = 32; off >= 1; off >>= 1) s += shx(s, off, lane);
        const float mean = s * (1.f / 1024.f); float q = 0.f;
#pragma unroll
        for (int i = 0; i < 4; ++i) { v[i] = v[i] - mean; q += (v[i][0] * v[i][0] + v[i][1] * v[i][1]) + (v[i][2] * v[i][2] + v[i][3] * v[i][3]); }
#pragma unroll
        for (int off = 32; off >= 1; off >>= 1) q += shx(q, off, lane);
        const float rstd = 1.0f / sqrtf(q * (1.f / 1024.f) + 1e-5f);
#pragma unroll
        for (int i = 0; i < 4; ++i) {
            const f32x4 o = v[i] * rstd * gv[i] + bv[i];
            *(f32x4*)(XF + (size_t)row * DM + (i * 64 + lane) * 4) = o;
            *(u32x2*)(XB + (size_t)row * DM + (i * 64 + lane) * 4) = pk4(o);
        }
    }
}

#define XB_TMO      128
#define XB_XCNT(j)  (256  + 64 * (j))
#define XB_XSUB(j)  (1280 + 64 * (j))
#define XB_XGEN(j)  (2304 + 64 * (j))
#define XB_TOP      3328
#define XB_TOPGEN   3392
#define XCD_BAR_WORDS 3456
#define XB_SPIN_CAP (1u << 22)
__device__ __forceinline__ unsigned xb_ld(unsigned* p)              { return __hip_atomic_load(p, __ATOMIC_RELAXED, __HIP_MEMORY_SCOPE_AGENT); }
__device__ __forceinline__ unsigned xb_add(unsigned* p, unsigned v) { return __hip_atomic_fetch_add(p, v, __ATOMIC_RELAXED, __HIP_MEMORY_SCOPE_AGENT); }
__device__ __forceinline__ unsigned xb_xcc_id() { return (unsigned)__builtin_amdgcn_s_getreg((3 << 11) | 20) & 0xFu; }
#define XB_SPIN(cond, bar) do { unsigned _sp = 0; while (cond) { __builtin_amdgcn_s_sleep(1); \
    if ((++_sp & 255u) == 0u) { if (xb_ld(&(bar)[XB_TMO])) break; if (_sp > XB_SPIN_CAP) { atomicAdd(&(bar)[XB_TMO], 1u); break; } } } } while (0)
__device__ __forceinline__ bool xb_leader(int wave_id) { return wave_id == 0 && lane_id_opaque() == 0; }
__device__ __forceinline__ void xcd_barrier_complete(unsigned* bar, unsigned x, unsigned G, unsigned& nloc, unsigned& nx) {
    unsigned sum, cnt, mine, sp = 0u;
    for (;;) {
        sum = 0u; cnt = 0u; mine = 0u;
#pragma unroll
        for (unsigned j = 0; j < 16; ++j) { const unsigned c = xb_ld(&bar[XB_XCNT(j)]); sum += c; cnt += (c > 0u) ? 1u : 0u; mine = (j == x) ? c : mine; }
        if (sum == G) break;
        __builtin_amdgcn_s_sleep(1);
        if ((++sp & 255u) == 0u) { if (xb_ld(&bar[XB_TMO])) break; if (sp > XB_SPIN_CAP) { atomicAdd(&bar[XB_TMO], 1u); break; } }
    }
    nloc = mine > 0u ? mine : 1u; nx = cnt > 0u ? cnt : 1u;
}
__device__ __forceinline__ void grid_barrier(unsigned* bar, volatile LAS unsigned* st, unsigned G, int wave_id) {
    asm volatile("s_waitcnt vmcnt(0)" ::: "memory");
    __syncthreads();
    if (xb_leader(wave_id)) {
        const unsigned x = xb_xcc_id();
        __builtin_amdgcn_s_waitcnt(0);
        unsigned nloc = st[0], nx = st[1];
        if (nloc == 0u) { xcd_barrier_complete(bar, x, G, nloc, nx); st[0] = nloc; st[1] = nx; }
        const unsigned old = xb_add(&bar[XB_XSUB(x)], 1u);
        const unsigned gen = old / nloc;
        if (old + 1u == (gen + 1u) * nloc) {
            __builtin_amdgcn_fence(__ATOMIC_RELEASE, "agent");
            asm volatile("s_waitcnt vmcnt(0)" ::: "memory");
            const unsigned og = xb_add(&bar[XB_TOP], 1u);
            const unsigned tg = og / nx;
            if (og + 1u == (tg + 1u) * nx) xb_add(&bar[XB_TOPGEN], 1u);
            else XB_SPIN(xb_ld(&bar[XB_TOPGEN]) == tg, bar);
            __builtin_amdgcn_fence(__ATOMIC_ACQUIRE, "agent");
            xb_add(&bar[XB_XGEN(x)], 1u);
            asm volatile("s_waitcnt vmcnt(0)" ::: "memory");
        } else {
            XB_SPIN(xb_ld(&bar[XB_XGEN(x)]) == gen, bar);
            __builtin_amdgcn_fence(__ATOMIC_ACQUIRE, "agent");
            asm volatile("s_waitcnt vmcnt(0)" ::: "memory");
        }
    }
    __syncthreads();
}

struct Args { const float* in[21]; float* out; unsigned char* ws; int ph_lo, ph_hi; };

__global__ void __launch_bounds__(512) mega(Args a) {
    extern __shared__ __attribute__((aligned(16))) unsigned char lds_raw[];
    LAS unsigned char* lds = (LAS unsigned char*)lds_raw;
    const int G0 = gridDim.x, cid0 = blockIdx.x;
    const int wave_id = __builtin_amdgcn_readfirstlane((int)threadIdx.x >> 6);
    if (a.ph_hi > 4096) cg::this_grid().sync();
    volatile LAS unsigned* bar_st = (volatile LAS unsigned*)(lds + 131072);
    if (xb_leader(wave_id)) { bar_st[0] = 0u; bar_st[1] = 0u; if (a.ph_hi - a.ph_lo > 1) (void)xb_add((unsigned*)(a.ws + WS_BAR) + XB_XCNT(xb_xcc_id()), 1u); }
    __syncthreads();

#ifndef REP_MASK
#define REP_MASK 0
#endif
    for (int pp = a.ph_lo * 2; pp < a.ph_hi * 2; ++pp) {
        const int p = pp >> 1;
        if ((pp & 1) && !((REP_MASK >> p) & 1)) continue;
        const __attribute__((address_space(4))) Args* ap = (const __attribute__((address_space(4))) Args*)__builtin_amdgcn_kernarg_segment_ptr(); asm volatile("" : "+s"(ap));
        int G = G0, cid = cid0; asm volatile("" : "+s"(G), "+s"(cid));
        unsigned char* ws = ap->ws;
    float* SSQ = (float*)(ws + WS_SSQ); float* ROPE = (float*)(ws + WS_ROPE);
    h16* WINA = (h16*)(ws + WS_WINA); h16* WUQ = (h16*)(ws + WS_WUQ); h16* WUKV = (h16*)(ws + WS_WUKV); h16* WOUTA = (h16*)(ws + WS_WOUTA);
    h16* WINC = (h16*)(ws + WS_WINC); h16* WOUTC = (h16*)(ws + WS_WOUTC); h16* W13 = (h16*)(ws + WS_W13); h16* W2 = (h16*)(ws + WS_W2);
    h16* WG = (h16*)(ws + WS_WG); h16* WP = (h16*)(ws + WS_WP);
    float* FLT = (float*)(ws + WS_FLT); h16* PB = (h16*)(ws + WS_PB); h16* XBA = (h16*)(ws + WS_XBA); h16* XBB = (h16*)(ws + WS_XBB);
    h16* U = (h16*)(ws + WS_U); float* XF = (float*)(ws + WS_XF); float* Y = ap->out;
    float* STATS = (float*)(ws + WS_STATS); float* CVEC = (float*)(ws + WS_CVEC);
    h16* CQ = (h16*)(ws + WS_CQ); h16* CKV = (h16*)(ws + WS_CKV); h16* QA = (h16*)(ws + WS_QA); h16* KA = (h16*)(ws + WS_KA); h16* VAT = (h16*)(ws + WS_VAT);
    h16* QB = (h16*)(ws + WS_QB); h16* KB = (h16*)(ws + WS_KB); h16* VBT = (h16*)(ws + WS_VBT); h16* OCAT = (h16*)(ws + WS_OCAT);
    h16* Q1 = (h16*)(ws + WS_Q1); h16* K1 = (h16*)(ws + WS_K1); h16* VT1 = (h16*)(ws + WS_VT1);
        int q = p, L = 0;
        if (p >= 12) { q = p - 8; L = 1; }
        if (PH_EN(0) && p == 0) {
            int tid0 = wave_id * 64 + lane_id_opaque(); asm volatile("" : "+v"(tid0));
            int gthreads = G * 512; asm volatile("" : "+s"(gthreads));
            const int gtid = cid * 512 + tid0;
            { const float* w = ap->in[2];
              prep_w(lds, WINA, NIN_A, 1024, 2080, nullptr, [=](int n) -> const float* { return n < 1536 ? w + 544 + n : n < 2048 ? w + (n - 1536) : n < 2080 ? w + 512 + (n - 2048) : nullptr; }, cid, G, tid0); }
            { const float* w = ap->in[4]; prep_w(lds, WUQ, 768, 256, 768, ap->in[3], [=](int n) -> const float* { return w + n; }, cid, G, tid0); }
            { const float* w = ap->in[6]; prep_w(lds, WUKV, 1024, 256, 1024, ap->in[5], [=](int n) -> const float* { return w + n; }, cid, G, tid0); }
            { const float* w = ap->in[7]; prep_w(lds, WOUTA, 1024, 1024, 1024, nullptr, [=](int n) -> const float* { return w + n; }, cid, G, tid0); }
            { const float* w = ap->in[8]; prep_w(lds, WINC, NIN_C, 1024, 3088, nullptr, [=](int n) -> const float* { return n < 3088 ? w + n : nullptr; }, cid, G, tid0); }
            { const float* w = ap->in[10]; prep_w(lds, WOUTC, 1024, 1024, 1024, nullptr, [=](int n) -> const float* { return w + n; }, cid, G, tid0); }
            for (int l = 0; l < 2; ++l) {
                { const float* w1 = ap->in[11] + (size_t)l * 1024 * DFF; const float* w3 = ap->in[12] + (size_t)l * 1024 * DFF;
                  prep_w(lds, W13 + (size_t)l * 5632 * 1024, 5632, 1024, DFF, ap->in[14] + l * DM, [=](int n) -> const float* { const int tl = n >> 8, r = n & 255; return w1 + (r < 128 ? (ptrdiff_t)0 : (w3 - w1)) + tl * 128 + (r & 127); }, cid, G, tid0,
                         CVEC + (size_t)(l * 2) * CV_N, CVEC + (size_t)(l * 2 + 1) * CV_N, ap->in[15] + l * DM); }
                { const float* w = ap->in[13] + (size_t)l * DFF * 1024; prep_w(lds, W2 + (size_t)l * 1024 * DFF, 1024, DFF, 1024, nullptr, [=](int n) -> const float* { return w + n; }, cid, G, tid0); }
                { const float* w = ap->in[19] + (size_t)l * 1024 * 1024; prep_w(lds, WG + (size_t)l * 1024 * 1024, 1024, 1024, 1024, ap->in[16] + l * DM, [=](int n) -> const float* { return w + n; }, cid, G, tid0,
                         CVEC + (size_t)(l * 2) * CV_N + 5632, CVEC + (size_t)(l * 2 + 1) * CV_N + 5632, ap->in[17] + l * DM); }
                { const float* w = ap->in[18] + (size_t)l * 256 * 1024; prep_w(lds, WP + (size_t)l * 1024 * 256, 1024, 256, 1024, nullptr, [=](int n) -> const float* { return w + n; }, cid, G, tid0); }
            }
            cvt_rows(XBA, ap->in[0], (size_t)T * DM / 8, gtid, gthreads);
            cvt_rows(PB, ap->in[1], (size_t)2 * T * PD / 8, gtid, gthreads);
            { float zf = 0.f; asm volatile("" : "+v"(zf)); for (int i = gtid; i < T * 2; i += gthreads) SSQ[i] = zf; }
            for (int i = gtid; i < SEQ * 16; i += gthreads) {
                const int pos = i >> 4, fi = i & 15;
                double invd = 1.0;
#pragma unroll 1
                for (int e = 0; e < fi; ++e) invd *= 0.56234132519034907;
                const float inv = (float)invd;
                const float ang = (float)pos * inv;
                const double ad = (double)ang, k = rint(ad * 0.15915494309189535);
                const double r = (ad - k * 6.283185307179586) - k * 2.4492935982947064e-16;
                double sn, cs; sincos_d(r, sn, cs);
                ROPE[2 * i] = (float)cs; ROPE[2 * i + 1] = (float)sn;
            }
        } else if (PH_EN(1) && p == 1) {
            pg8::Gemm g{XBA, WINA, T, NIN_A, 1024}; pg8::StaticOrder S; S.init(T, NIN_A, G, cid);
            EpiInA E{QB, KB, VBT, CQ, CKV, KA, SSQ, ROPE};
            pg8::gemm_phase(lds, g, S, E, wave_id);
        } else if (PH_EN(2) && p == 2) {
            { pg8::Gemm g{CQ, WUQ, T, 768, 256}; pg8::StaticOrder S; S.init(T, 768, G, cid); EpiUq E{QA, SSQ, ROPE}; pg8::gemm_phase(lds, g, S, E, wave_id); }
            { pg8::Gemm g{CKV, WUKV, T, 1024, 256}; pg8::StaticOrder S; S.init(T, 1024, G, cid); EpiUkv E{KA, VAT, SSQ}; pg8::gemm_phase(lds, g, S, E, wave_id); }
        } else if (PH_EN(3) && p == 3) {
            for (int r = 0;; ++r) {
                const int u = r * G + ((r & 1) ? G - 1 - cid : cid);
                if (u >= 2048) break;
                const int qb = 15 - (u >> 7), sub = u & 127, bh = sub & 63, b = bh >> 3, h = bh & 7;
#ifndef P3_SKIP
#define P3_SKIP 9
#endif
                if (P3_SKIP != 1 && sub < 64) attn_unit<1>(lds, QB, KB, VBT, OCAT, 512 + h * 64, nullptr, b, bh, qb, wave_id);
                else if (P3_SKIP != 0) attn_unit<0>(lds, QA, KA, VAT, OCAT, h * 64, nullptr, b, bh, qb, wave_id);
            }
        } else if (PH_EN(10) && p == 10) {
            pg8::Gemm g{XBB, WINC, T, NIN_C, 1024}; pg8::StaticOrder S; S.init(T, NIN_C, G, cid);
            EpiInC E{Q1, K1, VT1, FLT, ap->in[9]};
            pg8::gemm_phase(lds, g, S, E, wave_id);
        } else if (PH_EN(11) && p == 11) {
            for (int r = 0;; ++r) {
                const int u = r * G + ((r & 1) ? G - 1 - cid : cid);
                if (u >= 2048) break;
                const int qb = 15 - (u >> 7), bh = u & 127, b = bh >> 4, h = bh & 15;
                attn_unit<2>(lds, Q1, K1, VT1, OCAT, h * 64, FLT, b, bh, qb, wave_id);
            }
        } else if (PH_EN(4) && (q == 4 || q == 7)) {
            pg8::Gemm g; EpiResLn E;
            if (q == 4) { g = pg8::Gemm{OCAT, L ? WOUTC : WOUTA, T, DM, 1024};
                          E = EpiResLn{L ? XBB : XBA, nullptr, nullptr, nullptr, nullptr, XBA, STATS + (size_t)(L * 2) * T * 2}; }
            else { g = pg8::Gemm{U, W2 + (size_t)L * 1024 * DFF, T, DM, DFF};
                   E = EpiResLn{nullptr, XBA, STATS + (size_t)(L * 2) * T * 2, ap->in[14] + L * DM, ap->in[15] + L * DM, XBA, STATS + (size_t)(L * 2 + 1) * T * 2}; }
            pg8::StaticOrder S; S.init(T, DM, G, cid);
            pg8::gemm_phase<EpiResLn, pg8::StaticOrder, false, true>(lds, g, S, E, wave_id);
        } else if (q == 5 || q == 8) {
            continue;
        } else if (PH_EN(6) && q == 6) {
            pg8::Gemm g{XBA, W13 + (size_t)L * 5632 * 1024, T, 5632, 1024}; pg8::StaticOrder S; S.init(T, 5632, G, cid);
            EpiSwiglu E{U, STATS + (size_t)(L * 2) * T * 2, CVEC + (size_t)(L * 2) * CV_N, CVEC + (size_t)(L * 2 + 1) * CV_N};
            pg8::gemm_phase(lds, g, S, E, wave_id);
        } else if (PH_EN(9) && q == 9) {
            pg8::StaticOrder S; S.init(T, DM, G, cid);
            { pg8::Gemm g{PB + (size_t)L * T * PD, WP + (size_t)L * 1024 * 256, T, DM, 256}; EpiStoreF32 E{(h16*)(ws + WS_Q1)}; pg8::gemm_phase(lds, g, S, E, wave_id); }
            { pg8::Gemm g{XBA, WG + (size_t)L * 1024 * 1024, T, DM, 1024};
              EpiPle E{XBA, STATS + (size_t)(L * 2 + 1) * T * 2, ap->in[16] + L * DM, ap->in[17] + L * DM, CVEC + (size_t)(L * 2) * CV_N + 5632, CVEC + (size_t)(L * 2 + 1) * CV_N + 5632, Y, ap->in[20] + L * DM, L ? nullptr : XBB, (const h16*)(ws + WS_Q1)};
              pg8::gemm_phase(lds, g, S, E, wave_id); }
        }
        if (pp + 1 < a.ph_hi * 2) grid_barrier((unsigned*)(ws + WS_BAR), bar_st, (unsigned)G, wave_id);
    }
}

extern "C" void kernel_launch(void* const* d_in, const int* in_sizes, int n_in, void* d_out, int out_size, void* d_ws, size_t ws_size, hipStream_t stream) {
    static int grid = 0;
    if (grid == 0) {
        if (n_in != 21 || out_size != T * DM || ws_size < WS_END) { fprintf(stderr, "kernel_launch: unexpected problem (n_in %d, out %d, ws %zu)\n", n_in, out_size, ws_size); grid = -1; return; }
        int dev = 0, cus = 0, per_cu = 0;
        hipGetDevice(&dev); hipDeviceGetAttribute(&cus, hipDeviceAttributeMultiprocessorCount, dev);
        if (hipFuncSetAttribute((const void*)mega, hipFuncAttributeMaxDynamicSharedMemorySize, LDS_BYTES) != hipSuccess) { fprintf(stderr, "kernel_launch: hipFuncSetAttribute failed\n"); grid = -1; return; }
        if (hipOccupancyMaxActiveBlocksPerMultiprocessor(&per_cu, (const void*)mega, 512, LDS_BYTES) != hipSuccess || per_cu < 1) { fprintf(stderr, "kernel_launch: occupancy query says %d\n", per_cu); per_cu = 1; }
        (void)hipGetLastError();
        grid = cus;
        fprintf(stderr, "kernel_launch: grid %d (per_cu %d)\n", grid, per_cu);
    }
    if (grid < 0) return;
    Args a{};
    for (int i = 0; i < 21; ++i) a.in[i] = (const float*)d_in[i];
    a.out = (float*)d_out; a.ws = (unsigned char*)d_ws;
#if MK_ONE_LAUNCH
    (void)hipMemsetAsync((char*)d_ws + WS_BAR, 0, 16384, stream);
    (void)hipMemsetAsync((char*)d_ws + WS_STATS, 0, WS_ZERO_BYTES, stream);
    a.ph_lo = 0; a.ph_hi = NPHASE;
    void* args[] = {&a};
    hipError_t e = hipLaunchCooperativeKernel((const void*)mega, dim3(grid), dim3(512), args, LDS_BYTES, stream);
    if (e != hipSuccess) fprintf(stderr, "cooperative launch failed: %s (grid %d)\n", hipGetErrorString(e), grid);
#else
    for (int p = 0; p < NPHASE; ++p) {
        a.ph_lo = p; a.ph_hi = p + 1;
        hipLaunchKernelGGL(mega, dim3(grid), dim3(512), LDS_BYTES, stream, a);
    }
#endif
}
```

```cpp
#include <hip/hip_runtime.h>
#include <hip/hip_cooperative_groups.h>
#include <cstdio>
#include <cstdint>
#include <type_traits>
namespace cg = cooperative_groups;

#define LAS __attribute__((address_space(3)))
typedef _Float16 h16;
typedef _Float16 h16x2 __attribute__((ext_vector_type(2)));
typedef _Float16 h16x4 __attribute__((ext_vector_type(4)));
typedef _Float16 h16x8 __attribute__((ext_vector_type(8)));
typedef float f32x2 __attribute__((ext_vector_type(2)));
typedef float f32x4 __attribute__((ext_vector_type(4)));
typedef float f32x16 __attribute__((ext_vector_type(16)));
typedef unsigned u32x2 __attribute__((ext_vector_type(2)));
typedef unsigned u32x4 __attribute__((ext_vector_type(4)));

#ifndef MK_ONE_LAUNCH
#define MK_ONE_LAUNCH 1
#endif

constexpr int SEQ = 4096, NB = 8, T = NB * SEQ, DM = 1024, DFF = 2816, PD = 256;
constexpr int NIN_A = 2304;
constexpr int NIN_C = 3328;
constexpr float ALPHA = 1.41421356237309515f;
constexpr float LOG2E = 1.44269504088896341f;
constexpr float QS_MLA = 0.10206207261596575f * LOG2E;
constexpr float QS_64 = 0.125f * LOG2E;
constexpr int NPHASE = 18;
#ifndef PH_MASK
#define PH_MASK 0xFFFFF
#endif
#define PH_EN(k) ((PH_MASK >> (k)) & 1)

constexpr size_t MiB = 1u << 20;
constexpr size_t WS_SSQ = 0;
constexpr size_t WS_BAR = 384 * 1024;
constexpr size_t WS_ROPE = 512 * 1024;
constexpr size_t WS_WINA = 1 * MiB;
constexpr size_t WS_WUQ = WS_WINA + (size_t)NIN_A * 1024 * 2;
constexpr size_t WS_WUKV = WS_WUQ + 768 * 256 * 2;
constexpr size_t WS_WOUTA = WS_WUKV + 1024 * 256 * 2;
constexpr size_t WS_WINC = WS_WOUTA + 1024 * 1024 * 2;
constexpr size_t WS_WOUTC = WS_WINC + (size_t)NIN_C * 1024 * 2;
constexpr size_t WS_W13 = WS_WOUTC + 1024 * 1024 * 2;
constexpr size_t WS_W2 = WS_W13 + (size_t)2 * 5632 * 1024 * 2;
constexpr size_t WS_WG = WS_W2 + (size_t)2 * 1024 * 2816 * 2;
constexpr size_t WS_WP = WS_WG + (size_t)2 * 1024 * 1024 * 2;
constexpr size_t WS_WEND = WS_WP + (size_t)2 * 1024 * 256 * 2;
static_assert(WS_WEND <= 62 * MiB, "weights region");
constexpr size_t WS_STATS = 56 * MiB;
constexpr size_t WS_CVEC = 57 * MiB;
constexpr size_t WS_ZERO_BYTES = 1 * MiB + 128 * 1024;
constexpr int CV_N = 6656;
static_assert(WS_WEND <= WS_STATS, "weights vs stats");
constexpr size_t WS_FLT = 62 * MiB;
constexpr size_t WS_PB = 64 * MiB;
constexpr size_t WS_XBA = 96 * MiB;
constexpr size_t WS_R1 = 160 * MiB;
constexpr size_t WS_U = WS_R1;
constexpr size_t WS_XBB = WS_R1;
constexpr size_t WS_XF = WS_R1 + 176 * MiB;
constexpr size_t WS_CQ = WS_R1, WS_CKV = WS_R1 + 16 * MiB, WS_QA = WS_R1 + 32 * MiB, WS_KA = WS_R1 + 80 * MiB, WS_VAT = WS_R1 + 128 * MiB;
constexpr size_t WS_QB = WS_R1 + 160 * MiB, WS_KB = WS_R1 + 192 * MiB, WS_VBT = WS_R1 + 224 * MiB, WS_OCAT = WS_R1 + 256 * MiB;
constexpr size_t WS_Q1 = WS_R1 + 64 * MiB, WS_K1 = WS_R1 + 128 * MiB, WS_VT1 = WS_R1 + 192 * MiB;
constexpr size_t WS_END = WS_R1 + 320 * MiB;

constexpr int LDS_BYTES = 131072 + 1024;

__device__ __forceinline__ int lane_id_opaque() { unsigned z = 0u; asm volatile("" : "+v"(z)); return (int)__builtin_amdgcn_mbcnt_hi(~0u, __builtin_amdgcn_mbcnt_lo(~0u, z)); }
namespace pg8 {
constexpr int BM = 256, BK = 64, HALF = 128, HTB = HALF * BK * 2, NXCD = 8, WGM = 8;
__host__ __device__ __forceinline__ int lds_byte(int r, int c) { const int st = (r >> 4) * 2 + (c >> 5), rr = r & 15, cc = c & 31, ob = rr * 64 + cc * 2; return st * 1024 + (ob ^ (((ob >> 9) & 1) << 5)); }
__host__ __device__ __forceinline__ void stage_rc(int b, int& R, int& C) { const int st = b / 1024, sb = b % 1024, swz = sb ^ (((sb >> 9) & 1) << 5); R = (st >> 1) * 16 + swz / 64; C = (st & 1) * 32 + (swz % 64) / 2; }
__host__ __device__ __forceinline__ int perm32(int rho) { const int n = rho >> 4, i = rho & 15; return 8 * (i >> 2) + 4 * n + (i & 3); }

struct Unit { int pm, pn; };
struct Gemm { const h16* A; const h16* Bt; int M, N, K; };

struct StaticOrder {
    int nM, nN, nwg, G, c;
    __device__ void init(int M, int N, int G_, int c_) { nM = M / BM; nN = N / BM; nwg = nM * nN; G = G_; c = c_; }
    __device__ bool next(int i, Unit& u) const {
        const long L = (long)i * G + c; if (L >= nwg) return false;
        int wgid = (int)L; { const int q = nwg / NXCD, r = nwg % NXCD, xcd = wgid % NXCD, off = wgid / NXCD; wgid = (xcd < r ? xcd * (q + 1) : r * (q + 1) + (xcd - r) * q) + off; }
        const int nig = WGM * nN, gid = wgid / nig, fm = gid * WGM, gsz = (nM - fm) < WGM ? (nM - fm) : WGM;
        u.pm = fm + ((wgid % nig) % gsz); u.pn = (wgid % nig) / gsz; return true;
    }
};

template <class Epi, class Sched, bool ALIGN_EPI = true, bool SP2 = true>
__device__ __forceinline__ void gemm_phase(LAS unsigned char* lds, const Gemm g, const Sched& S, const Epi& E, int wave_id) {
    int lane_ = lane_id_opaque(); asm volatile("" : "+v"(lane_));
    const int wid = wave_id, lane = lane_, tid = wid * 64 + lane, wr = wid >> 2, wc = wid & 3, fr = lane & 15, fq = lane >> 4;
    const int K = g.K, nt = K / BK;
    unsigned voffA[2], voffB[2];
#pragma unroll
    for (int i = 0; i < 2; ++i) { int R, C; stage_rc(tid * 16 + i * 8192, R, C); const int Rb = Epi::PERM ? ((R & ~31) + perm32(R & 31)) : R;
        voffA[i] = (unsigned)(R * K + C) * 2u; voffB[i] = (unsigned)(Rb * K + C) * 2u; }
    const size_t kstep = (size_t)(BK * 2);
    const size_t hstep = (size_t)HALF * K * 2;
    const size_t tstep = 2 * hstep;
    const unsigned ldsw = (unsigned)wid * 1024u;
    const int aoff = lds_byte(wr * 64 + fr, fq * 8), boff = lds_byte(wc * 32 + fr, fq * 8);
#define PG8_SA(b, h) (((b) * 2 + (h)) * HTB)
#define PG8_SB(b, h) ((4 + (b) * 2 + (h)) * HTB)
#define PG8_STAGE(bufoff, gbase, voff) do { _Pragma("unroll") for (int _i = 0; _i < 2; ++_i) \
        __builtin_amdgcn_global_load_lds((const unsigned*)((const char*)(gbase) + (voff)[_i]), (LAS unsigned*)(lds + (bufoff) + ldsw + _i * 8192), 16, 0, 0); } while (0)
#define PG8_LDA(dst, b, h) do { _Pragma("unroll") for (int m = 0; m < 4; ++m) _Pragma("unroll") for (int k = 0; k < 2; ++k) dst[m][k] = *(const LAS h16x8*)(lds + PG8_SA(b, h) + aoff + m * 2048 + k * 1024); } while (0)
#define PG8_LDB(dst, b, h) do { _Pragma("unroll") for (int n = 0; n < 2; ++n) _Pragma("unroll") for (int k = 0; k < 2; ++k) dst[n][k] = *(const LAS h16x8*)(lds + PG8_SB(b, h) + boff + n * 2048 + k * 1024); } while (0)
#define PG8_MMA(ai, bj, At, Bt) do { __builtin_amdgcn_s_setprio(1); _Pragma("unroll") for (int m = 0; m < 4; ++m) _Pragma("unroll") for (int n = 0; n < 2; ++n) _Pragma("unroll") for (int k = 0; k < 2; ++k) \
        acc[ai][bj][m][n] = __builtin_amdgcn_mfma_f32_16x16x32_f16(Bt[n][k], At[m][k], acc[ai][bj][m][n], 0, 0, 0); __builtin_amdgcn_s_setprio(0); } while (0)
#define PG8_WAIT_V(n) asm volatile("s_waitcnt vmcnt(" #n ")" ::: "memory")
#define PG8_WAIT_L(n) asm volatile("s_waitcnt lgkmcnt(" #n ")" ::: "memory")
#define PG8_BAR __builtin_amdgcn_s_barrier()
#define PG8_SCHED __builtin_amdgcn_sched_barrier(0)
    Unit cur, nxt; int ui = 0;
    if (!S.next(0, cur)) return;
    f32x4 acc[2][2][4][2];
#pragma unroll
    for (int a = 0; a < 2; ++a)
#pragma unroll
        for (int b = 0; b < 2; ++b)
#pragma unroll
            for (int m = 0; m < 4; ++m)
#pragma unroll
                for (int n = 0; n < 2; ++n) acc[a][b][m][n] = (f32x4){0.f, 0.f, 0.f, 0.f};
    h16x8 At[4][2], B0[2][2], B1[2][2];
    const char* cA = (const char*)g.A + (size_t)cur.pm * tstep; const char* cB = (const char*)g.Bt + (size_t)cur.pn * tstep;
    if constexpr (SP2) {
        PG8_STAGE(PG8_SB(0, 0), cB, voffB); PG8_STAGE(PG8_SB(0, 1), cB + hstep, voffB); PG8_STAGE(PG8_SA(0, 0), cA, voffA); PG8_STAGE(PG8_SA(0, 1), cA + hstep, voffA);
        if (wr == 1) PG8_BAR;
        PG8_WAIT_V(2); PG8_BAR;
        PG8_STAGE(PG8_SB(1, 0), cB + kstep, voffB); PG8_STAGE(PG8_SA(1, 0), cA + kstep, voffA); PG8_STAGE(PG8_SB(1, 1), cB + hstep + kstep, voffB);
        PG8_WAIT_V(6); PG8_BAR;
    } else {
        PG8_STAGE(PG8_SB(0, 0), cB, voffB); PG8_STAGE(PG8_SA(0, 0), cA, voffA); PG8_STAGE(PG8_SB(0, 1), cB + hstep, voffB); PG8_STAGE(PG8_SA(0, 1), cA + hstep, voffA);
        if (wr == 1) PG8_BAR;
        PG8_WAIT_V(4); PG8_BAR;
        PG8_STAGE(PG8_SB(1, 0), cB + kstep, voffB); PG8_STAGE(PG8_SA(1, 0), cA + kstep, voffA); PG8_STAGE(PG8_SB(1, 1), cB + hstep + kstep, voffB);
        PG8_WAIT_V(6); PG8_BAR;
    }
    for (;;) {
        const bool has_next = S.next(ui + 1, nxt);
        const char* nA = has_next ? (const char*)g.A + (size_t)nxt.pm * tstep : cA; const char* nB = has_next ? (const char*)g.Bt + (size_t)nxt.pn * tstep : cB;
        for (int t = 0; t < nt; t += 2) {
            const bool last = (t == nt - 2);
            const char* a1 = cA + (size_t)(t + 1) * kstep;
            const char* a2 = last ? nA : cA + (size_t)(t + 2) * kstep; const char* b2 = last ? nB : cB + (size_t)(t + 2) * kstep;
            const char* a3 = a2 + kstep; const char* b3 = b2 + kstep;
            if constexpr (SP2) {
            PG8_LDB(B0, 0, 0); PG8_LDB(B1, 0, 1); PG8_SCHED; PG8_LDA(At, 0, 0); PG8_STAGE(PG8_SA(1, 1), a1 + hstep, voffA);
            PG8_WAIT_V(8); PG8_WAIT_L(0); PG8_BAR; PG8_MMA(0, 0, At, B0); PG8_MMA(0, 1, At, B1); PG8_BAR; PG8_SCHED;
            PG8_LDA(At, 0, 1); PG8_STAGE(PG8_SB(0, 0), b2, voffB); PG8_STAGE(PG8_SB(0, 1), b2 + hstep, voffB); PG8_STAGE(PG8_SA(0, 0), a2, voffA);
            PG8_WAIT_V(8); PG8_WAIT_L(0); PG8_BAR; PG8_MMA(1, 0, At, B0); PG8_MMA(1, 1, At, B1); PG8_BAR; PG8_SCHED;
            PG8_LDB(B0, 1, 0); PG8_LDB(B1, 1, 1); PG8_SCHED; PG8_LDA(At, 1, 0); PG8_STAGE(PG8_SA(0, 1), a2 + hstep, voffA);
            PG8_WAIT_V(8); PG8_WAIT_L(0); PG8_BAR; PG8_MMA(0, 0, At, B0); PG8_MMA(0, 1, At, B1); PG8_BAR; PG8_SCHED;
            PG8_LDA(At, 1, 1); PG8_STAGE(PG8_SB(1, 0), b3, voffB); PG8_STAGE(PG8_SB(1, 1), b3 + hstep, voffB); PG8_STAGE(PG8_SA(1, 0), a3, voffA);
            PG8_WAIT_V(8); PG8_WAIT_L(0); PG8_BAR; PG8_MMA(1, 0, At, B0); PG8_MMA(1, 1, At, B1); PG8_BAR; PG8_SCHED;
            } else {
            PG8_LDB(B0, 0, 0); PG8_SCHED; PG8_LDA(At, 0, 0); PG8_STAGE(PG8_SA(1, 1), a1 + hstep, voffA);
            PG8_WAIT_L(8); PG8_BAR; PG8_WAIT_L(0); PG8_MMA(0, 0, At, B0); PG8_BAR; PG8_SCHED;
            PG8_LDB(B1, 0, 1); PG8_STAGE(PG8_SB(0, 0), b2, voffB);
            PG8_BAR; PG8_WAIT_L(0); PG8_MMA(0, 1, At, B1); PG8_BAR;
            PG8_LDA(At, 0, 1); PG8_STAGE(PG8_SA(0, 0), a2, voffA);
            PG8_BAR; PG8_WAIT_L(0); PG8_MMA(1, 0, At, B0); PG8_BAR; PG8_SCHED;
            PG8_STAGE(PG8_SB(0, 1), b2 + hstep, voffB);
            PG8_WAIT_V(6); PG8_BAR; PG8_MMA(1, 1, At, B1); PG8_BAR;
            PG8_LDB(B0, 1, 0); PG8_SCHED; PG8_LDA(At, 1, 0); PG8_STAGE(PG8_SA(0, 1), a2 + hstep, voffA);
            PG8_WAIT_L(8); PG8_BAR; PG8_WAIT_L(0); PG8_MMA(0, 0, At, B0); PG8_BAR; PG8_SCHED;
            PG8_LDB(B1, 1, 1); PG8_STAGE(PG8_SB(1, 0), b3, voffB);
            PG8_BAR; PG8_WAIT_L(0); PG8_MMA(0, 1, At, B1); PG8_BAR;
            PG8_LDA(At, 1, 1); PG8_STAGE(PG8_SA(1, 0), a3, voffA);
            PG8_BAR; PG8_WAIT_L(0); PG8_MMA(1, 0, At, B0); PG8_BAR; PG8_SCHED;
            PG8_STAGE(PG8_SB(1, 1), b3 + hstep, voffB);
            PG8_WAIT_V(6); PG8_BAR; PG8_MMA(1, 1, At, B1); PG8_BAR;
            }
        }
        if constexpr (ALIGN_EPI) { if (wr == 0) PG8_BAR; }
        { const int ln_ = lane_id_opaque(); int fr_ = ln_ & 15, fq_ = ln_ >> 4; asm volatile("" : "+v"(fr_), "+v"(fq_));
          E(acc, cur, wr, wc, fr_, fq_); }
        if (!has_next) break;
#pragma unroll
        for (int a = 0; a < 2; ++a)
#pragma unroll
            for (int b = 0; b < 2; ++b)
#pragma unroll
                for (int m = 0; m < 4; ++m)
#pragma unroll
                    for (int n = 0; n < 2; ++n) acc[a][b][m][n] = (f32x4){0.f, 0.f, 0.f, 0.f};
        cur = nxt; cA = nA; cB = nB; ++ui;
        if constexpr (ALIGN_EPI) { if (wr == 1) PG8_BAR; }
    }
    PG8_WAIT_V(0);
    if constexpr (!ALIGN_EPI) { if (wr == 0) PG8_BAR; }
    PG8_BAR;
#undef PG8_SA
#undef PG8_SB
#undef PG8_STAGE
#undef PG8_LDA
#undef PG8_LDB
#undef PG8_MMA
#undef PG8_WAIT_V
#undef PG8_WAIT_L
#undef PG8_BAR
#undef PG8_SCHED
}
}

typedef float acc_t[2][2][4][2][4];
using pg8::Unit;
#define ACC_ARG const f32x4 (&acc)[2][2][4][2]

__device__ __forceinline__ float shx(float x, int mask, int lane) { return __builtin_bit_cast(float, __builtin_amdgcn_ds_bpermute((lane ^ mask) << 2, __builtin_bit_cast(int, x))); }
__device__ __forceinline__ float shup(float x, int off, int lane) { return __builtin_bit_cast(float, __builtin_amdgcn_ds_bpermute((lane - off) << 2, __builtin_bit_cast(int, x))); }
__device__ __forceinline__ unsigned pk2(float a, float b) { h16x2 v; v.x = (h16)a; v.y = (h16)b; return __builtin_bit_cast(unsigned, v); }
__device__ __forceinline__ u32x2 pk4(f32x4 v) { u32x2 r; r.x = pk2(v[0], v[1]); r.y = pk2(v[2], v[3]); return r; }
__device__ __forceinline__ unsigned pk2z(float a, float b) { return __builtin_bit_cast(unsigned, __builtin_amdgcn_cvt_pkrtz(a, b)); }

struct EpiInA {
    static constexpr bool PERM = false;
    h16 *QB, *KB, *VBT, *CQ, *CKV, *KA; float* SSQ; const float* ROPE;
    __device__ __forceinline__ void operator()(ACC_ARG, const Unit& u, int wr, int wc, int fr, int fq) const {
        const int pn = u.pn;
        if (pn == 8 && wc != 0) return;
#pragma unroll
        for (int ai = 0; ai < 2; ++ai)
#pragma unroll
            for (int m = 0; m < 4; ++m) {
                const int row = u.pm * 256 + ai * 128 + wr * 64 + m * 16 + fr, b = row >> 12, s = row & 4095;
                if (pn < 6) {
#pragma unroll
                    for (int bj = 0; bj < 2; ++bj)
#pragma unroll
                        for (int n = 0; n < 2; ++n) {
                            const int c = (pn & 1) * 256 + bj * 128 + wc * 32 + n * 16 + fq * 4, head = c >> 6, d = c & 63;
                            f32x4 v = acc[ai][bj][m][n];
                            if (pn < 2) { v = v * QS_64; *(u32x2*)(QB + ((size_t)(b * 8 + head) * SEQ + s) * 64 + d) = pk4(v); }
                            else if (pn < 4) { *(u32x2*)(KB + ((size_t)(b * 8 + head) * SEQ + s) * 64 + d) = pk4(v); }
                            else { h16* vp = VBT + ((size_t)(b * 8 + head) * 64 + (s >> 6)) * 4096 + (size_t)d * 64 + (s & 63);
#pragma unroll
                                for (int e = 0; e < 4; ++e) vp[e * 64] = (h16)v[e]; }
                        }
                } else if (pn < 8) {
                    h16* dst = (pn == 6 ? CQ : CKV) + (size_t)row * 256;
                    float ss = 0.f;
#pragma unroll
                    for (int bj = 0; bj < 2; ++bj)
#pragma unroll
                        for (int n = 0; n < 2; ++n) {
                            const f32x4 v = acc[ai][bj][m][n];
                            ss += (v[0] * v[0] + v[1] * v[1]) + (v[2] * v[2] + v[3] * v[3]);
                            *(u32x2*)(dst + bj * 128 + wc * 32 + n * 16 + fq * 4) = pk4(v);
                        }
                    { const int ln = fr + 16 * fq; ss += shx(ss, 16, ln); ss += shx(ss, 32, ln); }
                    if (fq == 0) atomicAdd(SSQ + (size_t)row * 2 + (pn - 6), ss);
                } else {
                    const f32x4 x1 = acc[ai][0][m][0], x2 = acc[ai][0][m][1];
                    const float* rp = ROPE + ((size_t)s * 16 + fq * 4) * 2;
                    const f32x4 cs0 = *(const f32x4*)rp, cs1 = *(const f32x4*)(rp + 4);
                    f32x4 o1, o2;
                    o1[0] = x1[0] * cs0[0] - x2[0] * cs0[1]; o2[0] = x1[0] * cs0[1] + x2[0] * cs0[0];
                    o1[1] = x1[1] * cs0[2] - x2[1] * cs0[3]; o2[1] = x1[1] * cs0[3] + x2[1] * cs0[2];
                    o1[2] = x1[2] * cs1[0] - x2[2] * cs1[1]; o2[2] = x1[2] * cs1[1] + x2[2] * cs1[0];
                    o1[3] = x1[3] * cs1[2] - x2[3] * cs1[3]; o2[3] = x1[3] * cs1[3] + x2[3] * cs1[2];
                    const u32x2 p1 = pk4(o1), p2 = pk4(o2);
#pragma unroll
                    for (int h = 0; h < 8; ++h) { h16* kp = KA + ((size_t)(b * 8 + h) * SEQ + s) * 96 + 64 + fq * 4; *(u32x2*)kp = p1; *(u32x2*)(kp + 16) = p2; }
                }
            }
    }
};

struct EpiUq {
    static constexpr bool PERM = false;
    h16* QA; const float* SSQ; const float* ROPE;
    __device__ __forceinline__ void operator()(ACC_ARG, const Unit& u, int wr, int wc, int fr, int fq) const {
        float ssv[2][4];
#pragma unroll
        for (int ai = 0; ai < 2; ++ai)
#pragma unroll
            for (int m = 0; m < 4; ++m) ssv[ai][m] = SSQ[(size_t)(u.pm * 256 + ai * 128 + wr * 64 + m * 16 + fr) * 2 + 0];
        __builtin_amdgcn_sched_barrier(0);
#pragma unroll
        for (int ai = 0; ai < 2; ++ai)
#pragma unroll
            for (int m = 0; m < 4; ++m) {
                const int row = u.pm * 256 + ai * 128 + wr * 64 + m * 16 + fr, b = row >> 12, s = row & 4095;
                const float rs = __builtin_amdgcn_rsqf(ssv[ai][m] * (1.f / 256.f) + 1e-6f) * QS_MLA;
#pragma unroll
                for (int bj = 0; bj < 2; ++bj) {
                    const int g32 = u.pn * 8 + bj * 4 + wc, head = g32 / 3, part = g32 - head * 3;
                    h16* qp = QA + ((size_t)(b * 8 + head) * SEQ + s) * 96;
                    if (part < 2) {
#pragma unroll
                        for (int n = 0; n < 2; ++n) *(u32x2*)(qp + part * 32 + n * 16 + fq * 4) = pk4(acc[ai][bj][m][n] * rs);
                    } else {
                        const f32x4 x1 = acc[ai][bj][m][0] * rs, x2 = acc[ai][bj][m][1] * rs;
                        const float* rp = ROPE + ((size_t)s * 16 + fq * 4) * 2;
                        const f32x4 cs0 = *(const f32x4*)rp, cs1 = *(const f32x4*)(rp + 4);
                        f32x4 o1, o2;
                        o1[0] = x1[0] * cs0[0] - x2[0] * cs0[1]; o2[0] = x1[0] * cs0[1] + x2[0] * cs0[0];
                        o1[1] = x1[1] * cs0[2] - x2[1] * cs0[3]; o2[1] = x1[1] * cs0[3] + x2[1] * cs0[2];
                        o1[2] = x1[2] * cs1[0] - x2[2] * cs1[1]; o2[2] = x1[2] * cs1[1] + x2[2] * cs1[0];
                        o1[3] = x1[3] * cs1[2] - x2[3] * cs1[3]; o2[3] = x1[3] * cs1[3] + x2[3] * cs1[2];
                        *(u32x2*)(qp + 64 + fq * 4) = pk4(o1); *(u32x2*)(qp + 80 + fq * 4) = pk4(o2);
                    }
                }
            }
    }
};

struct EpiUkv {
    static constexpr bool PERM = false;
    h16 *KA, *VAT; const float* SSQ;
    __device__ __forceinline__ void operator()(ACC_ARG, const Unit& u, int wr, int wc, int fr, int fq) const {
        float ssv[2][4];
#pragma unroll
        for (int ai = 0; ai < 2; ++ai)
#pragma unroll
            for (int m = 0; m < 4; ++m) ssv[ai][m] = SSQ[(size_t)(u.pm * 256 + ai * 128 + wr * 64 + m * 16 + fr) * 2 + 1];
        __builtin_amdgcn_sched_barrier(0);
#pragma unroll
        for (int ai = 0; ai < 2; ++ai)
#pragma unroll
            for (int m = 0; m < 4; ++m) {
                const int row = u.pm * 256 + ai * 128 + wr * 64 + m * 16 + fr, b = row >> 12, s = row & 4095;
                const float rs = __builtin_amdgcn_rsqf(ssv[ai][m] * (1.f / 256.f) + 1e-6f);
#pragma unroll
                for (int bj = 0; bj < 2; ++bj) {
                    const int head = u.pn * 2 + bj;
#pragma unroll
                    for (int n = 0; n < 2; ++n) {
                        const f32x4 v = acc[ai][bj][m][n] * rs;
                        const int e128 = wc * 32 + n * 16 + fq * 4;
                        if (wc < 2) *(u32x2*)(KA + ((size_t)(b * 8 + head) * SEQ + s) * 96 + e128) = pk4(v);
                        else { h16* vp = VAT + ((size_t)(b * 8 + head) * 64 + (s >> 6)) * 4096 + (size_t)(e128 - 64) * 64 + (s & 63);
#pragma unroll
                            for (int e = 0; e < 4; ++e) vp[e * 64] = (h16)v[e]; }
                    }
                }
            }
    }
};

__device__ __forceinline__ void ln_stats(const float* st, size_t row, float& mu, float& rs) {
    const f32x2 v = *(const f32x2*)(st + row * 2);
    mu = v.x * (1.f / 1024.f);
    const float var = fmaxf(v.y * (1.f / 1024.f) - mu * mu, 0.f);
    rs = __builtin_amdgcn_rsqf(var + 1e-5f);
}
struct EpiResLn {
    static constexpr bool PERM = true; static constexpr bool PREFETCH = false;
    const h16* X; const h16* XS; const float* st_in; const float* g_in; const float* b_in;
    h16* Yh; float* st_out;
    __device__ __forceinline__ void operator()(ACC_ARG, const Unit& u, int wr, int wc, int fr, int fq) const {
        const int ln = fr + 16 * fq;
        const h16* src = X ? X : XS;
        u32x4 xin[2][4]; f32x4 gg[2][2], bb[2][2];
        float sy[4], sq[4], mu[4], rs[4];
        auto loadq = [&](int b, int buf) {
            const int ai = b >> 1, bj = b & 1, col = u.pn * 256 + bj * 128 + wc * 32 + fq * 8;
            const size_t row0 = (size_t)(u.pm * 256 + ai * 128 + wr * 64 + fr);
#pragma unroll
            for (int m = 0; m < 4; ++m) xin[buf][m] = *(const u32x4*)(src + (row0 + 16 * m) * DM + col);
            if (!X) {
#pragma unroll
                for (int n = 0; n < 2; ++n) { gg[buf][n] = *(const f32x4*)(g_in + col + 4 * n); bb[buf][n] = *(const f32x4*)(b_in + col + 4 * n); }
            }
        };
        loadq(0, 0);
#pragma unroll
        for (int b = 0; b < 4; ++b) {
            const int ai = b >> 1, bj = b & 1, buf = b & 1, col = u.pn * 256 + bj * 128 + wc * 32 + fq * 8;
            const size_t row0 = (size_t)(u.pm * 256 + ai * 128 + wr * 64 + fr);
            if (bj == 0) {
#pragma unroll
                for (int m = 0; m < 4; ++m) { sy[m] = 0.f; sq[m] = 0.f; mu[m] = 0.f; rs[m] = 1.f; if (!X) ln_stats(st_in, row0 + 16 * m, mu[m], rs[m]); }
            }
            if (b + 1 < 4) loadq(b + 1, buf ^ 1);
            __builtin_amdgcn_sched_barrier(0);
#pragma unroll
            for (int m = 0; m < 4; ++m) {
                const h16x8 xh = __builtin_bit_cast(h16x8, xin[buf][m]); u32x4 w;
#pragma unroll
                for (int n = 0; n < 2; ++n) {
                    f32x4 x; x[0] = (float)xh[4 * n]; x[1] = (float)xh[4 * n + 1]; x[2] = (float)xh[4 * n + 2]; x[3] = (float)xh[4 * n + 3];
                    if (!X) x = (x - mu[m]) * rs[m] * gg[buf][n] + bb[buf][n];
                    const f32x4 y = x * ALPHA + acc[ai][bj][m][n];
                    sy[m] += (y[0] + y[1]) + (y[2] + y[3]); sq[m] += (y[0] * y[0] + y[1] * y[1]) + (y[2] * y[2] + y[3] * y[3]);
                    const u32x2 p = pk4(y); if (n == 0) { w.x = p.x; w.y = p.y; } else { w.z = p.x; w.w = p.y; }
                }
                *(u32x4*)(Yh + (row0 + 16 * m) * DM + col) = w;
            }
            if (bj == 1) {
#pragma unroll
                for (int m = 0; m < 4; ++m) {
                    float a = sy[m], c = sq[m];
                    a += shx(a, 16, ln); a += shx(a, 32, ln); c += shx(c, 16, ln); c += shx(c, 32, ln);
                    if (fq == 0) { atomicAdd(st_out + (row0 + 16 * m) * 2, a); atomicAdd(st_out + (row0 + 16 * m) * 2 + 1, c); }
                }
            }
        }
    }
};

struct EpiSwiglu {
    static constexpr bool PERM = true;
    h16* U; const float* st; const float* c1; const float* c2;
    __device__ __forceinline__ void operator()(ACC_ARG, const Unit& u, int wr, int wc, int fr, int fq) const {
        f32x4 k1[2][2], k2[2][2];
#pragma unroll
        for (int bj = 0; bj < 2; ++bj)
#pragma unroll
            for (int n = 0; n < 2; ++n) { const int nd = u.pn * 256 + bj * 128 + wc * 32 + fq * 8 + 4 * n; k1[bj][n] = *(const f32x4*)(c1 + nd); k2[bj][n] = *(const f32x4*)(c2 + nd); }
        float mus[2][4], rss[2][4];
#pragma unroll
        for (int ai = 0; ai < 2; ++ai)
#pragma unroll
            for (int m = 0; m < 4; ++m) ln_stats(st, (size_t)(u.pm * 256 + ai * 128 + wr * 64 + m * 16 + fr), mus[ai][m], rss[ai][m]);
#pragma unroll
        for (int ai = 0; ai < 2; ++ai)
#pragma unroll
            for (int m = 0; m < 4; ++m) {
                const size_t row = (size_t)(u.pm * 256 + ai * 128 + wr * 64 + m * 16 + fr);
                const float mu = mus[ai][m], rs = rss[ai][m];
                u32x4 w;
#pragma unroll
                for (int n = 0; n < 2; ++n) {
                    const f32x4 g = (acc[ai][0][m][n] - k1[0][n] * mu) * rs + k2[0][n], up = (acc[ai][1][m][n] - k1[1][n] * mu) * rs + k2[1][n]; f32x4 h;
#pragma unroll
                    for (int e = 0; e < 4; ++e) h[e] = g[e] * __builtin_amdgcn_rcpf(1.f + __builtin_amdgcn_exp2f(-g[e] * LOG2E)) * up[e];
                    const u32x2 p = pk4(h); if (n == 0) { w.x = p.x; w.y = p.y; } else { w.z = p.x; w.w = p.y; }
                }
                *(u32x4*)(U + row * DFF + u.pn * 128 + wc * 32 + fq * 8) = w;
            }
    }
};

struct EpiStoreF32 {
    static constexpr bool PERM = true;
    h16* P;
    __device__ __forceinline__ void operator()(ACC_ARG, const Unit& u, int wr, int wc, int fr, int fq) const {
#pragma unroll
        for (int ai = 0; ai < 2; ++ai)
#pragma unroll
            for (int m = 0; m < 4; ++m) {
                const size_t row = (size_t)(u.pm * 256 + ai * 128 + wr * 64 + m * 16 + fr);
#pragma unroll
                for (int bj = 0; bj < 2; ++bj) {
                    const size_t o = row * DM + u.pn * 256 + bj * 128 + wc * 32 + fq * 8;
                    const u32x2 p0 = pk4(acc[ai][bj][m][0]), p1 = pk4(acc[ai][bj][m][1]); u32x4 w; w.x = p0.x; w.y = p0.y; w.z = p1.x; w.w = p1.y;
                    *(u32x4*)(P + o) = w;
                }
            }
    }
};

struct EpiPle {
    static constexpr bool PERM = true;
    const h16* Y2; const float* st; const float* g2; const float* b2; const float* c1; const float* c2; float* Y; const float* bg; h16* XBo; const h16* PJ;
    __device__ __forceinline__ void operator()(ACC_ARG, const Unit& u, int wr, int wc, int fr, int fq) const {
        float mu[2][4], rs[2][4];
#pragma unroll
        for (int ai = 0; ai < 2; ++ai)
#pragma unroll
            for (int m = 0; m < 4; ++m) ln_stats(st, (size_t)(u.pm * 256 + ai * 128 + wr * 64 + m * 16 + fr), mu[ai][m], rs[ai][m]);
#pragma unroll
        for (int bj = 0; bj < 2; ++bj) {
            const int col = u.pn * 256 + bj * 128 + wc * 32 + fq * 8;
            f32x4 gg[2], b2v[2], k1[2], k2b[2];
#pragma unroll
            for (int n = 0; n < 2; ++n) { gg[n] = *(const f32x4*)(g2 + col + 4 * n); b2v[n] = *(const f32x4*)(b2 + col + 4 * n); k1[n] = *(const f32x4*)(c1 + col + 4 * n);
                                          k2b[n] = *(const f32x4*)(c2 + col + 4 * n) + *(const f32x4*)(bg + col + 4 * n); }
#pragma unroll
            for (int ai = 0; ai < 2; ++ai) {
#pragma unroll
              for (int mh = 0; mh < 2; ++mh) {
                u32x4 pin[4], yin[4];
#pragma unroll
                for (int m = 2 * mh; m < 2 * mh + 2; ++m) { const size_t o = (size_t)(u.pm * 256 + ai * 128 + wr * 64 + m * 16 + fr) * DM + col; pin[m] = *(const u32x4*)(PJ + o); yin[m] = *(const u32x4*)(Y2 + o); }
                __builtin_amdgcn_sched_barrier(0);
#pragma unroll
                for (int m = 2 * mh; m < 2 * mh + 2; ++m) {
                    const size_t o = (size_t)(u.pm * 256 + ai * 128 + wr * 64 + m * 16 + fr) * DM + col;
                    u32x4 w; const h16x8 pj = __builtin_bit_cast(h16x8, pin[m]), yh = __builtin_bit_cast(h16x8, yin[m]);
#pragma unroll
                    for (int n = 0; n < 2; ++n) {
                        f32x4 ys; ys[0] = (float)yh[4 * n]; ys[1] = (float)yh[4 * n + 1]; ys[2] = (float)yh[4 * n + 2]; ys[3] = (float)yh[4 * n + 3];
                        f32x4 pr; pr[0] = (float)pj[4 * n]; pr[1] = (float)pj[4 * n + 1]; pr[2] = (float)pj[4 * n + 2]; pr[3] = (float)pj[4 * n + 3];
                        const f32x4 x = (ys - mu[ai][m]) * rs[ai][m] * gg[n] + b2v[n];
                        const f32x4 z = (acc[ai][bj][m][n] - k1[n] * mu[ai][m]) * rs[ai][m] + k2b[n]; f32x4 r;
#pragma unroll
                        for (int e = 0; e < 4; ++e) r[e] = x[e] + __builtin_amdgcn_rcpf(1.f + __builtin_amdgcn_exp2f(-z[e] * LOG2E)) * pr[e];
                        if (!XBo) *(f32x4*)(Y + o + 4 * n) = r;
                        const u32x2 p = pk4(r); if (n == 0) { w.x = p.x; w.y = p.y; } else { w.z = p.x; w.w = p.y; }
                    }
                    if (XBo) *(u32x4*)(XBo + o) = w;
                }
              }
            }
        }
    }
};

struct EpiInC {
    static constexpr bool PERM = true;
    h16 *Q1, *K1, *VT1; float* FLT; const float* bf;
    __device__ __forceinline__ void operator()(ACC_ARG, const Unit& u, int wr, int wc, int fr, int fq) const {
        const int pn = u.pn;
        if (pn == 12 && (wc != 0 || fq >= 2)) return;
#pragma unroll
        for (int ai = 0; ai < 2; ++ai)
#pragma unroll
            for (int m = 0; m < 4; ++m) {
                const int row = u.pm * 256 + ai * 128 + wr * 64 + m * 16 + fr, b = row >> 12, s = row & 4095;
                if (pn < 12) {
#pragma unroll
                    for (int bj = 0; bj < 2; ++bj) {
                        const int head = (pn & 3) * 4 + bj * 2 + (wc >> 1), d = (wc & 1) * 32 + fq * 8;
                        f32x4 v0 = acc[ai][bj][m][0], v1 = acc[ai][bj][m][1];
                        if (pn < 8) {
                            if (pn < 4) { v0 = v0 * QS_64; v1 = v1 * QS_64; }
                            h16* dst = (pn < 4 ? Q1 : K1) + ((size_t)(b * 16 + head) * SEQ + s) * 64 + d;
                            const u32x2 p0 = pk4(v0), p1 = pk4(v1); u32x4 w; w.x = p0.x; w.y = p0.y; w.z = p1.x; w.w = p1.y;
                            *(u32x4*)dst = w;
                        } else {
                            h16* vp = VT1 + ((size_t)(b * 16 + head) * 64 + (s >> 6)) * 4096 + (size_t)d * 64 + (s & 63);
#pragma unroll
                            for (int e = 0; e < 4; ++e) { vp[e * 64] = (h16)v0[e]; vp[(4 + e) * 64] = (h16)v1[e]; }
                        }
                    }
                } else {
#pragma unroll
                    for (int n = 0; n < 2; ++n)
#pragma unroll
                        for (int e = 0; e < 4; ++e) {
                            const int hd = fq * 8 + n * 4 + e;
                            const float z = (acc[ai][0][m][n][e] + bf[hd]) * LOG2E;
                            const float ls = fminf(z, 0.f) - __builtin_amdgcn_logf(1.f + __builtin_amdgcn_exp2f(-fabsf(z)));
                            FLT[(size_t)(b * 16 + hd) * SEQ + s] = ls;
                        }
                }
            }
    }
};

constexpr int AT_KBYTES = 13312, AT_VOFF = 2 * AT_KBYTES, AT_VBYTES = 9216, AT_DCOFF = AT_VOFF + 2 * AT_VBYTES, AT_WSOFF = AT_DCOFF + 16384;
template <int MODE>
__device__ __forceinline__ void attn_unit(LAS unsigned char* lds, const h16* __restrict__ Qg, const h16* __restrict__ Kg, const h16* __restrict__ VTg,
                                          h16* __restrict__ Og, int ocol, const float* __restrict__ FLTg, int b, int bh, int qb, int wave_id) {
    constexpr int D = (MODE == 0) ? 96 : 64, KRS = (D + 8) * 2, VRS = 144, NDS = D / 16;
    constexpr float THR = 8.0f;
    int lane_ = lane_id_opaque(); asm volatile("" : "+v"(lane_));
    const int lane = lane_, w = wave_id, tid = w * 64 + lane, j = lane & 31, hh = lane >> 5;
    const int q0 = qb * 256, qw = q0 + 32 * w, nkt = 4 * qb + 4, kt_last = qw >> 6;
    const int it0 = nkt - 1 - kt_last;
    const int pij = (j & 0x13) | ((j & 4) << 1) | ((j & 8) >> 1);
    const int tqd = 32 * (w & 1) + j;
    LAS float* DC = (LAS float*)(lds + AT_DCOFF);
    asm volatile("s_waitcnt lgkmcnt(0)\n\ts_barrier" ::: "memory");
    h16x8 qf[NDS];
    { const h16* qrow = Qg + ((size_t)bh * SEQ + qw + j) * D + 8 * hh;
#pragma unroll
      for (int ds = 0; ds < NDS; ++ds) qf[ds] = *(const h16x8*)(qrow + 16 * ds); }
    const int srow = tid >> 3, sch = tid & 7;
    struct StageRegs { u32x4 k0, k1, v; };
    StageRegs RA, RB;
    const int koff0 = (MODE == 0) ? (tid / 12) * 96 + (tid % 12) * 8 : srow * 64 + sch * 8;
    const int koff1 = (MODE == 0) ? ((tid + 512) / 12) * 96 + ((tid + 512) % 12) * 8 : 0;
    const int voff = srow * 64 + sch * 8;
    auto gloadK = [&](int kt, StageRegs& r) {
        const h16* kbase = Kg + ((size_t)bh * SEQ + (size_t)kt * 64) * D;
        r.k0 = *(const u32x4*)(kbase + koff0);
        if constexpr (MODE == 0) { if (tid < 256) r.k1 = *(const u32x4*)(kbase + koff1); }
    };
    auto gloadV = [&](int kt, StageRegs& r) { const h16* vbase = VTg + ((size_t)bh * 64 + (size_t)kt) * 4096; r.v = *(const u32x4*)(vbase + voff); };
    auto lstoreK = [&](int buf, const StageRegs& r) {
        if constexpr (MODE == 0) {
            const int c0 = tid, r0 = c0 / 12, h0 = c0 - r0 * 12;
            *(LAS u32x4*)(lds + buf * AT_KBYTES + r0 * KRS + h0 * 16) = r.k0;
            if (tid < 256) { const int c1 = tid + 512, r1 = c1 / 12, h1 = c1 - r1 * 12; *(LAS u32x4*)(lds + buf * AT_KBYTES + r1 * KRS + h1 * 16) = r.k1; }
        } else {
            *(LAS u32x4*)(lds + buf * AT_KBYTES + srow * KRS + sch * 16) = r.k0;
        }
    };
    auto lstoreV = [&](int buf, const StageRegs& r) { *(LAS u32x4*)(lds + AT_VOFF + buf * AT_VBYTES + srow * VRS + sch * 16) = r.v; };
    auto lds_barrier = [&]() { asm volatile("s_waitcnt lgkmcnt(0)\n\ts_barrier" ::: "memory"); };
    gloadK(nkt - 1, RA); gloadV(nkt - 1, RA); if constexpr (MODE != 1) gloadK(nkt - 2, RB);
    float dt = 0.f;
    if constexpr (MODE == 2) {
        const float* src = FLTg + (size_t)bh * SEQ + 8 * tid;
        const f32x4 a = *(const f32x4*)src, c = *(const f32x4*)(src + 4);
        float v[8] = {a[0], a[1], a[2], a[3], c[0], c[1], c[2], c[3]};
#pragma unroll
        for (int i = 1; i < 8; ++i) v[i] += v[i - 1];
        float x = v[7];
#pragma unroll
        for (int off = 1; off < 64; off <<= 1) { const float y = shup(x, off, lane); if (lane >= off) x += y; }
        LAS float* WS = (LAS float*)(lds + AT_WSOFF);
        if (lane == 63) WS[w] = x;
        asm volatile("s_waitcnt lgkmcnt(0)\n\ts_barrier" ::: "memory");
        float woff = 0.f;
#pragma unroll
        for (int i = 0; i < 8; ++i) { const float t = WS[i]; if (i < w) woff += t; }
        const float excl = x - v[7] + woff;
#pragma unroll
        for (int i = 0; i < 8; ++i) DC[8 * tid + i] = excl + v[i];
        asm volatile("s_waitcnt lgkmcnt(0)\n\ts_barrier" ::: "memory");
        dt = DC[qw + j];
    }
    f32x16 oacc[2];
#pragma unroll
    for (int i = 0; i < 16; ++i) { oacc[0][i] = 0.f; oacc[1][i] = 0.f; }
    float m_run = 0.f, R = (MODE == 1) ? 1.f : 0.f;
    f32x16 lacc;
#pragma unroll
    for (int i = 0; i < 16; ++i) lacc[i] = 0.f;
    h16x8 onesf;
#pragma unroll
    for (int i = 0; i < 8; ++i) onesf[i] = (j == 0) ? (h16)1.0f : (h16)0.0f;
    auto ST = [&](f32x16 (&s)[2], int it, auto diag_c) {
        constexpr bool DIAG = decltype(diag_c)::value;
        const int kt = nkt - 1 - it;
#pragma unroll
        for (int ks = 0; ks < 2; ++ks) {
            if constexpr (MODE == 2) {
                const float base = dt - m_run;
#pragma unroll
                for (int run = 0; run < 2; ++run) {
                    const LAS float* dk = DC + 64 * kt + 32 * ks + 16 * run + 8 * hh;
                    const f32x4 d0 = *(const LAS f32x4*)dk, d1 = *(const LAS f32x4*)(dk + 4);
#pragma unroll
                    for (int e = 0; e < 4; ++e) { s[ks][8 * run + e] = base - d0[e]; s[ks][8 * run + 4 + e] = base - d1[e]; }
                }
            } else {
                const float base = (MODE == 0) ? -m_run : 0.f;
#pragma unroll
                for (int r = 0; r < 16; ++r) s[ks][r] = base;
            }
            if constexpr (DIAG && MODE != 0) {
#pragma unroll
                for (int r = 0; r < 16; ++r) { const int kq = 32 * ks + 16 * (r >> 3) + 8 * hh + (r & 7); if (MODE == 1 ? (kq >= tqd) : (kq > tqd)) s[ks][r] = -1e30f; }
            }
            const LAS unsigned char* kb = lds + (it & 1) * AT_KBYTES + (32 * ks + pij) * KRS + hh * 16;
#pragma unroll
            for (int ds = 0; ds < NDS; ++ds) s[ks] = __builtin_amdgcn_mfma_f32_32x32x16_f16(*(const LAS h16x8*)(kb + ds * 32), qf[ds], s[ks], 0, 0, 0);
        }
    };
    auto BMAX = [&](f32x16 (&s)[2], bool first) {
        if constexpr (MODE != 1) {
            float tmx = fmaxf(s[0][0], s[1][0]);
#pragma unroll
            for (int r = 1; r < 16; ++r) tmx = fmaxf(tmx, fmaxf(s[0][r], s[1][r]));
            tmx = fmaxf(tmx, shx(tmx, 32, lane));
            if (first || __builtin_amdgcn_ballot_w64(tmx > THR) != 0ull) {
                const float delta = (first || tmx > THR) ? tmx : 0.f;
                const float corr = first ? 1.f : __builtin_amdgcn_exp2f(-delta);
                m_run += delta; lacc[0] *= corr;
#pragma unroll
                for (int i = 0; i < 16; ++i) { oacc[0][i] *= corr; oacc[1][i] *= corr; s[0][i] -= delta; s[1][i] -= delta; }
            }
        }
    };
    auto SBRUN = [&](const f32x16& sv, int ks, int run, u32x4 (&pf)[4]) {
        float rb[8];
#pragma unroll
        for (int i = 0; i < 8; ++i) {
            const float e = __builtin_amdgcn_exp2f(sv[8 * run + i]);
            rb[i] = __builtin_amdgcn_rcpf(1.f + e);
        }
        const float p = ((rb[0] * rb[1]) * (rb[2] * rb[3])) * ((rb[4] * rb[5]) * (rb[6] * rb[7]));
        const float pp = shx(p, 32, lane);
        float c = R * (hh == 0 ? pp : 1.f);
        unsigned wd[4];
#pragma unroll
        for (int i = 3; i >= 0; --i) {
            const float ch = c * rb[2 * i + 1], ah = c - ch;
            const float cl = ch * rb[2 * i], al = ch - cl;
            c = cl; wd[i] = pk2z(al, ah);
        }
        u32x4 t; t.x = wd[0]; t.y = wd[1]; t.z = wd[2]; t.w = wd[3]; pf[2 * ks + run] = t;
        R *= p * pp;
    };
    auto CD = [&](f32x16 (&s)[2], int it) {
        u32x4 pf[4];
        if constexpr (MODE == 1) {
#pragma unroll
            for (int ks = 1; ks >= 0; --ks) { SBRUN(s[ks], ks, 1, pf); __builtin_amdgcn_sched_barrier(0); SBRUN(s[ks], ks, 0, pf); __builtin_amdgcn_sched_barrier(0); }
        } else {
#pragma unroll
            for (int ks = 0; ks < 2; ++ks) {
                float p[16];
#pragma unroll
                for (int r = 0; r < 16; ++r) p[r] = __builtin_amdgcn_exp2f(s[ks][r]);
#pragma unroll
                for (int run = 0; run < 2; ++run) { u32x4 t; t.x = pk2z(p[8 * run], p[8 * run + 1]); t.y = pk2z(p[8 * run + 2], p[8 * run + 3]); t.z = pk2z(p[8 * run + 4], p[8 * run + 5]); t.w = pk2z(p[8 * run + 6], p[8 * run + 7]); pf[2 * ks + run] = t; }
            }
        }
#pragma unroll
        for (int st = 0; st < 4; ++st) {
            const h16x8 pb = __builtin_bit_cast(h16x8, pf[st]);
#pragma unroll
            for (int dvt = 0; dvt < 2; ++dvt) {
                const LAS unsigned char* vb = lds + AT_VOFF + (it & 1) * AT_VBYTES + (32 * dvt + j) * VRS + st * 32 + hh * 16;
                oacc[dvt] = __builtin_amdgcn_mfma_f32_32x32x16_f16(*(const LAS h16x8*)vb, pb, oacc[dvt], 0, 0, 0);
            }
            if constexpr (MODE != 1) lacc = __builtin_amdgcn_mfma_f32_32x32x16_f16(onesf, pb, lacc, 0, 0, 0);
        }
    };
    auto FUSED = [&](f32x16 (&sc)[2], f32x16 (&sn)[2], int it) {
        constexpr int NA = 2 * NDS, NCH = NA > 8 ? NA : 8;
        const int ktn = nkt - 2 - it;
#pragma unroll
        for (int ks = 0; ks < 2; ++ks) {
            if constexpr (MODE == 2) {
                const float base = dt - m_run;
#pragma unroll
                for (int run = 0; run < 2; ++run) {
                    const LAS float* dk = DC + 64 * ktn + 32 * ks + 16 * run + 8 * hh;
                    const f32x4 d0 = *(const LAS f32x4*)dk, d1 = *(const LAS f32x4*)(dk + 4);
#pragma unroll
                    for (int e = 0; e < 4; ++e) { sn[ks][8 * run + e] = base - d0[e]; sn[ks][8 * run + 4 + e] = base - d1[e]; }
                }
            } else {
                const float base = (MODE == 0) ? -m_run : 0.f;
#pragma unroll
                for (int r = 0; r < 16; ++r) sn[ks][r] = base;
            }
        }
        const LAS unsigned char* kb = lds + ((it + 1) & 1) * AT_KBYTES + pij * KRS + hh * 16;
        const LAS unsigned char* vb = lds + AT_VOFF + (it & 1) * AT_VBYTES + j * VRS + hh * 16;
        h16x8 kf[NA];
        constexpr int PD = 4;
#pragma unroll
        for (int k = 0; k < PD; ++k) kf[k] = *(const LAS h16x8*)(kb + (k / NDS) * 32 * KRS + (k % NDS) * 32);
        u32x4 pf[4]; float pv[8];
        __builtin_amdgcn_sched_barrier(0);
#pragma unroll
        for (int k = 0; k < NCH; ++k) {
            if (k + PD < NA) kf[k + PD] = *(const LAS h16x8*)(kb + ((k + PD) / NDS) * 32 * KRS + ((k + PD) % NDS) * 32);
#ifdef PROBE_LDS
            if (k + 2 < NA) { const volatile LAS u32x4* dp = (const volatile LAS u32x4*)(kb + ((k + 2) / NDS) * 32 * KRS + ((k + 2) % NDS) * 32); u32x4 dd = *dp; asm volatile("" :: "v"(dd)); }
#endif
            if (k < NA) sn[k / NDS] = __builtin_amdgcn_mfma_f32_32x32x16_f16(kf[k], qf[k % NDS], sn[k / NDS], 0, 0, 0);
            if (k < 8) {
                const int ks = k >> 2;
#pragma unroll
                for (int e = 0; e < 4; ++e) {
                    const int r = 4 * (k & 3) + e;
                    { const float p = __builtin_amdgcn_exp2f(sc[ks][r]); pv[4 * (k & 1) + e] = p; }
#ifdef PROBE_VALU
                    { float zz = sc[ks][r]; asm volatile("" : "+v"(zz)); const float p2 = __builtin_amdgcn_exp2f(zz); float acc2 = p2 + 1.0f; asm volatile("" :: "v"(acc2)); }
#endif
                }
                if constexpr (MODE != 1) { if (k & 1) { u32x4 t; t.x = pk2z(pv[0], pv[1]); t.y = pk2z(pv[2], pv[3]); t.z = pk2z(pv[4], pv[5]); t.w = pk2z(pv[6], pv[7]); pf[k >> 1] = t; } }
            }
            __builtin_amdgcn_sched_barrier(0);
        }
        h16x8 vf[8];
#pragma unroll
        for (int k = 0; k < PD; ++k) vf[k] = *(const LAS h16x8*)(vb + (k & 1) * 32 * VRS + (k >> 1) * 32);
        float tmx = -3e38f;
        __builtin_amdgcn_sched_barrier(0);
#pragma unroll
        for (int k = 0; k < 8; ++k) {
            if (k + PD < 8) vf[k + PD] = *(const LAS h16x8*)(vb + ((k + PD) & 1) * 32 * VRS + ((k + PD) >> 1) * 32);
            oacc[k & 1] = __builtin_amdgcn_mfma_f32_32x32x16_f16(vf[k], __builtin_bit_cast(h16x8, pf[k >> 1]), oacc[k & 1], 0, 0, 0);
            if constexpr (MODE != 1) { if (k & 1) lacc = __builtin_amdgcn_mfma_f32_32x32x16_f16(onesf, __builtin_bit_cast(h16x8, pf[k >> 1]), lacc, 0, 0, 0); }
            if constexpr (MODE != 1) {
                const int ks = k >> 2, r0 = 4 * (k & 3);
                tmx = fmaxf(fmaxf(tmx, sn[ks][r0]), sn[ks][r0 + 1]); tmx = fmaxf(fmaxf(tmx, sn[ks][r0 + 2]), sn[ks][r0 + 3]);
            }
            __builtin_amdgcn_sched_barrier(0);
        }
        if constexpr (MODE != 1) {
            tmx = fmaxf(tmx, shx(tmx, 32, lane));
            if (__builtin_expect(__builtin_amdgcn_ballot_w64(tmx > THR) != 0ull, 0)) {
                const float delta = (tmx > THR) ? tmx : 0.f;
                const float corr = __builtin_amdgcn_exp2f(-delta);
                m_run += delta; lacc[0] *= corr;
#pragma unroll
                for (int i = 0; i < 16; ++i) { oacc[0][i] *= corr; oacc[1][i] *= corr; sn[0][i] -= delta; sn[1][i] -= delta; }
            }
        }
    };
    auto BMAXFIRST = [&](f32x16 (&s)[2]) {
        if constexpr (MODE != 1) {
            float tmx = fmaxf(s[0][0], s[1][0]);
#pragma unroll
            for (int r = 1; r < 16; ++r) tmx = fmaxf(fmaxf(tmx, s[0][r]), s[1][r]);
            tmx = fmaxf(tmx, shx(tmx, 32, lane));
            m_run += tmx;
#pragma unroll
            for (int i = 0; i < 16; ++i) { s[0][i] -= tmx; s[1][i] -= tmx; }
        }
    };
    auto STEP = [&](int it, f32x16 (&sc)[2], f32x16 (&sn)[2], StageRegs& rl, StageRegs& rs) {
        if constexpr (MODE == 1) { gloadK(max(nkt - 2 - it, 0), rs); gloadV(max(nkt - 2 - it, 0), rs); }
        else { gloadK(max(nkt - 4 - it, 0), rl); gloadV(max(nkt - 3 - it, 0), rl); }
        const bool act = it >= it0, actn = (it + 1 < nkt) && (it + 1 >= it0);
        if constexpr (MODE == 1) {
            if (act) { if (it == it0) ST(sc, it, std::true_type{}); else ST(sc, it, std::false_type{}); CD(sc, it); }
        } else if (act && actn) FUSED(sc, sn, it);
        else if (actn) { ST(sn, it + 1, std::true_type{}); BMAXFIRST(sn); }
        if constexpr (MODE == 1) { if (it + 1 < nkt) { lstoreK((it + 1) & 1, rs); lstoreV((it + 1) & 1, rs); } }
        else {
        if (it + 2 < nkt) lstoreK(it & 1, rs);
        if (it + 1 < nkt) lstoreV((it + 1) & 1, rs);
        }
        lds_barrier();
    };
    lstoreK(0, RA); lstoreV(0, RA); if constexpr (MODE != 1) lstoreK(1, RB);
    if constexpr (MODE != 1) { gloadK(nkt - 3, RB); gloadV(nkt - 2, RB); }
    lds_barrier();
    f32x16 sa[2], sb[2];
#pragma unroll
    for (int i = 0; i < 16; ++i) { sa[0][i] = 0.f; sa[1][i] = 0.f; sb[0][i] = 0.f; sb[1][i] = 0.f; }
    if constexpr (MODE != 1) { if (it0 == 0) { ST(sa, 0, std::true_type{}); BMAXFIRST(sa); } }
    lds_barrier();
    for (int it = 0; it < nkt; it += 2) { STEP(it, sa, sb, RA, RB); STEP(it + 1, sb, sa, RB, RA); }
    if constexpr (MODE != 1) CD(sb, nkt - 1);
    float inv = 1.f;
    if constexpr (MODE != 1) { const float l0 = lacc[0], lp = shx(l0, 32, lane); inv = 1.f / (hh ? lp : l0); }
    h16* op = Og + ((size_t)b * SEQ + qw + j) * DM + ocol + 4 * hh;
#pragma unroll
    for (int dvt = 0; dvt < 2; ++dvt)
#pragma unroll
        for (int g = 0; g < 4; ++g) {
            f32x4 v; v[0] = oacc[dvt][4 * g] * inv; v[1] = oacc[dvt][4 * g + 1] * inv; v[2] = oacc[dvt][4 * g + 2] * inv; v[3] = oacc[dvt][4 * g + 3] * inv;
            *(u32x2*)(op + 32 * dvt + 8 * g) = pk4(v);
        }
}

template <class F>
__device__ __forceinline__ void prep_w(LAS unsigned char* lds, h16* dst, int Nd, int K, int Ns, const float* kscale, F colptr, int cid, int G, int tid,
                                       float* c1 = nullptr, float* c2 = nullptr, const float* lnb = nullptr) {
    constexpr int NT = 4;
    const int tn = Nd >> 6, tk = K >> 6, ntiles = tn * tk;
    const int rn = tid & 63, rk = tid >> 6;
    const int wn = tid >> 3, wc = tid & 7;
    const float* dummy = colptr(0);
    for (int t0 = cid; t0 < ntiles; t0 += NT * G) {
        float v[NT][8]; bool nul[NT];
#pragma unroll
        for (int q = 0; q < NT; ++q) {
            const int t = min(t0 + q * G, ntiles - 1);
            const int n0 = (t % tn) << 6, k0 = (t / tn) << 6;
            const float* col = colptr(n0 + rn); nul[q] = (col == nullptr); if (nul[q]) col = dummy;
#pragma unroll
            for (int i = 0; i < 8; ++i) v[q][i] = col[(size_t)(k0 + rk + 8 * i) * Ns];
        }
#pragma unroll
        for (int q = 0; q < NT; ++q) {
            const int t = min(t0 + q * G, ntiles - 1);
            const int k0 = (t / tn) << 6;
            LAS h16* tile = (LAS h16*)lds + q * (64 * 72);
#pragma unroll
            for (int i = 0; i < 8; ++i) { float x = nul[q] ? 0.f : v[q][i]; if (kscale) x *= kscale[k0 + rk + 8 * i]; tile[rn * 72 + rk + 8 * i] = (h16)x; }
        }
        __syncthreads();
#pragma unroll
        for (int q = 0; q < NT; ++q) {
            const int t = t0 + q * G;
            if (t < ntiles) {
                const int n0 = (t % tn) << 6, k0 = (t / tn) << 6;
                LAS h16* tile = (LAS h16*)lds + q * (64 * 72);
                const u32x4 w = *(const LAS u32x4*)(tile + wn * 72 + wc * 8);
                *(u32x4*)(dst + (size_t)(n0 + wn) * K + k0 + wc * 8) = w;
                if (c1) {
                    const h16x8 hv = __builtin_bit_cast(h16x8, w);
                    float a1 = 0.f, a2 = 0.f;
#pragma unroll
                    for (int e = 0; e < 8; ++e) { const int kk = k0 + wc * 8 + e; const float f = (float)hv[e]; a1 += f; a2 += f * (lnb[kk] / kscale[kk]); }
                    const int ln = tid & 63;
                    a1 += shx(a1, 1, ln); a1 += shx(a1, 2, ln); a1 += shx(a1, 4, ln);
                    a2 += shx(a2, 1, ln); a2 += shx(a2, 2, ln); a2 += shx(a2, 4, ln);
                    if (wc == 0) { atomicAdd(c1 + n0 + wn, a1); atomicAdd(c2 + n0 + wn, a2); }
                }
            }
        }
        __syncthreads();
    }
}
__device__ __forceinline__ void cvt_rows(h16* dst, const float* src, size_t n8, int gtid, int gthreads) {
    size_t i = gtid;
    for (; i + 3 * (size_t)gthreads < n8; i += 4 * (size_t)gthreads) {
        f32x4 a[4], c[4];
#pragma unroll
        for (int q = 0; q < 4; ++q) { const size_t k = i + (size_t)q * gthreads; a[q] = __builtin_nontemporal_load((const f32x4*)(src + k * 8)); c[q] = __builtin_nontemporal_load((const f32x4*)(src + k * 8 + 4)); }
#pragma unroll
        for (int q = 0; q < 4; ++q) { const size_t k = i + (size_t)q * gthreads;
            u32x4 w; w.x = pk2(a[q][0], a[q][1]); w.y = pk2(a[q][2], a[q][3]); w.z = pk2(c[q][0], c[q][1]); w.w = pk2(c[q][2], c[q][3]);
            *(u32x4*)(dst + k * 8) = w; }
    }
    for (; i < n8; i += gthreads) {
        const f32x4 a = *(const f32x4*)(src + i * 8), c = *(const f32x4*)(src + i * 8 + 4);
        u32x4 w; w.x = pk2(a[0], a[1]); w.y = pk2(a[2], a[3]); w.z = pk2(c[0], c[1]); w.w = pk2(c[2], c[3]);
        *(u32x4*)(dst + i * 8) = w;
    }
}
__device__ __forceinline__ void sincos_d(double r, double& s, double& c) {
    const double r2 = r * r; double ts = r, tc = 1.0; s = r; c = 1.0;
#pragma unroll 1
    for (int n = 1; n <= 14; ++n) { tc *= -r2 / (double)((2 * n - 1) * (2 * n)); c += tc; ts *= -r2 / (double)((2 * n) * (2 * n + 1)); s += ts; }
}

__device__ __forceinline__ void ln_phase(const float* __restrict__ Y, float* __restrict__ XF, h16* __restrict__ XB, const float* __restrict__ g, const float* __restrict__ bt, int wave_id) {
    int lane_ = lane_id_opaque(); asm volatile("" : "+v"(lane_));
    const int lane = lane_, wg = blockIdx.x * 8 + wave_id, nw = gridDim.x * 8;
    f32x4 gv[4], bv[4];
#pragma unroll
    for (int i = 0; i < 4; ++i) { gv[i] = *(const f32x4*)(g + (i * 64 + lane) * 4); bv[i] = *(const f32x4*)(bt + (i * 64 + lane) * 4); }
    for (int row = wg; row < T; row += nw) {
        const float* y = Y + (size_t)row * DM; f32x4 v[4]; float s = 0.f;
#pragma unroll
        for (int i = 0; i < 4; ++i) { v[i] = *(const f32x4*)(y + (i * 64 + lane) * 4); s += (v[i][0] + v[i][1]) + (v[i][2] + v[i][3]); }
#pragma unroll
        for (int off = 32; off >= 1; off >>= 1) s += shx(s, off, lane);
        const float mean = s * (1.f / 1024.f); float q = 0.f;
#pragma unroll
        for (int i = 0; i < 4; ++i) { v[i] = v[i] - mean; q += (v[i][0] * v[i][0] + v[i][1] * v[i][1]) + (v[i][2] * v[i][2] + v[i][3] * v[i][3]); }
#pragma unroll
        for (int off = 32; off >= 1; off >>= 1) q += shx(q, off, lane);
        const float rstd = 1.0f / sqrtf(q * (1.f / 1024.f) + 1e-5f);
#pragma unroll
        for (int i = 0; i < 4; ++i) {
            const f32x4 o = v[i] * rstd * gv[i] + bv[i];
            *(f32x4*)(XF + (size_t)row * DM + (i * 64 + lane) * 4) = o;
            *(u32x2*)(XB + (size_t)row * DM + (i * 64 + lane) * 4) = pk4(o);
        }
    }
}

#define XB_TMO      128
#define XB_XCNT(j)  (256  + 64 * (j))
#define XB_XSUB(j)  (1280 + 64 * (j))
#define XB_XGEN(j)  (2304 + 64 * (j))
#define XB_TOP      3328
#define XB_TOPGEN   3392
#define XCD_BAR_WORDS 3456
#define XB_SPIN_CAP (1u << 22)
__device__ __forceinline__ unsigned xb_ld(unsigned* p)              { return __hip_atomic_load(p, __ATOMIC_RELAXED, __HIP_MEMORY_SCOPE_AGENT); }
__device__ __forceinline__ unsigned xb_add(unsigned* p, unsigned v) { return __hip_atomic_fetch_add(p, v, __ATOMIC_RELAXED, __HIP_MEMORY_SCOPE_AGENT); }
__device__ __forceinline__ unsigned xb_xcc_id() { return (unsigned)__builtin_amdgcn_s_getreg((3 << 11) | 20) & 0xFu; }
#define XB_SPIN(cond, bar) do { unsigned _sp = 0; while (cond) { __builtin_amdgcn_s_sleep(1); \
    if ((++_sp & 255u) == 0u) { if (xb_ld(&(bar)[XB_TMO])) break; if (_sp > XB_SPIN_CAP) { atomicAdd(&(bar)[XB_TMO], 1u); break; } } } } while (0)
__device__ __forceinline__ bool xb_leader(int wave_id) { return wave_id == 0 && lane_id_opaque() == 0; }
__device__ __forceinline__ void xcd_barrier_complete(unsigned* bar, unsigned x, unsigned G, unsigned& nloc, unsigned& nx) {
    unsigned sum, cnt, mine, sp = 0u;
    for (;;) {
        sum = 0u; cnt = 0u; mine = 0u;
#pragma unroll
        for (unsigned j = 0; j < 16; ++j) { const unsigned c = xb_ld(&bar[XB_XCNT(j)]); sum += c; cnt += (c > 0u) ? 1u : 0u; mine = (j == x) ? c : mine; }
        if (sum == G) break;
        __builtin_amdgcn_s_sleep(1);
        if ((++sp & 255u) == 0u) { if (xb_ld(&bar[XB_TMO])) break; if (sp > XB_SPIN_CAP) { atomicAdd(&bar[XB_TMO], 1u); break; } }
    }
    nloc = mine > 0u ? mine : 1u; nx = cnt > 0u ? cnt : 1u;
}
__device__ __forceinline__ void grid_barrier(unsigned* bar, volatile LAS unsigned* st, unsigned G, int wave_id) {
    asm volatile("s_waitcnt vmcnt(0)" ::: "memory");
    __syncthreads();
    if (xb_leader(wave_id)) {
        const unsigned x = xb_xcc_id();
        __builtin_amdgcn_s_waitcnt(0);
        unsigned nloc = st[0], nx = st[1];
        if (nloc == 0u) { xcd_barrier_complete(bar, x, G, nloc, nx); st[0] = nloc; st[1] = nx; }
        const unsigned old = xb_add(&bar[XB_XSUB(x)], 1u);
        const unsigned gen = old / nloc;
        if (old + 1u == (gen + 1u) * nloc) {
            __builtin_amdgcn_fence(__ATOMIC_RELEASE, "agent");
            asm volatile("s_waitcnt vmcnt(0)" ::: "memory");
            const unsigned og = xb_add(&bar[XB_TOP], 1u);
            const unsigned tg = og / nx;
            if (og + 1u == (tg + 1u) * nx) xb_add(&bar[XB_TOPGEN], 1u);
            else XB_SPIN(xb_ld(&bar[XB_TOPGEN]) == tg, bar);
            __builtin_amdgcn_fence(__ATOMIC_ACQUIRE, "agent");
            xb_add(&bar[XB_XGEN(x)], 1u);
            asm volatile("s_waitcnt vmcnt(0)" ::: "memory");
        } else {
            XB_SPIN(xb_ld(&bar[XB_XGEN(x)]) == gen, bar);
            __builtin_amdgcn_fence(__ATOMIC_ACQUIRE, "agent");
            asm volatile("s_waitcnt vmcnt(0)" ::: "memory");
        }
    }
    __syncthreads();
}

struct Args { const float* in[21]; float* out; unsigned char* ws; int ph_lo, ph_hi; };

__global__ void __launch_bounds__(512) mega(Args a) {
    extern __shared__ __attribute__((aligned(16))) unsigned char lds_raw[];
    LAS unsigned char* lds = (LAS unsigned char*)lds_raw;
    const int G0 = gridDim.x, cid0 = blockIdx.x;
    const int wave_id = __builtin_amdgcn_readfirstlane((int)threadIdx.x >> 6);
    if (a.ph_hi > 4096) cg::this_grid().sync();
    volatile LAS unsigned* bar_st = (volatile LAS unsigned*)(lds + 131072);
    if (xb_leader(wave_id)) { bar_st[0] = 0u; bar_st[1] = 0u; if (a.ph_hi - a.ph_lo > 1) (void)xb_add((unsigned*)(a.ws + WS_BAR) + XB_XCNT(xb_xcc_id()), 1u); }
    __syncthreads();

#ifndef REP_MASK
#define REP_MASK 0
#endif
    for (int pp = a.ph_lo * 2; pp < a.ph_hi * 2; ++pp) {
        const int p = pp >> 1;
        if ((pp & 1) && !((REP_MASK >> p) & 1)) continue;
        const __attribute__((address_space(4))) Args* ap = (const __attribute__((address_space(4))) Args*)__builtin_amdgcn_kernarg_segment_ptr(); asm volatile("" : "+s"(ap));
        int G = G0, cid = cid0; asm volatile("" : "+s"(G), "+s"(cid));
        unsigned char* ws = ap->ws;
    float* SSQ = (float*)(ws + WS_SSQ); float* ROPE = (float*)(ws + WS_ROPE);
    h16* WINA = (h16*)(ws + WS_WINA); h16* WUQ = (h16*)(ws + WS_WUQ); h16* WUKV = (h16*)(ws + WS_WUKV); h16* WOUTA = (h16*)(ws + WS_WOUTA);
    h16* WINC = (h16*)(ws + WS_WINC); h16* WOUTC = (h16*)(ws + WS_WOUTC); h16* W13 = (h16*)(ws + WS_W13); h16* W2 = (h16*)(ws + WS_W2);
    h16* WG = (h16*)(ws + WS_WG); h16* WP = (h16*)(ws + WS_WP);
    float* FLT = (float*)(ws + WS_FLT); h16* PB = (h16*)(ws + WS_PB); h16* XBA = (h16*)(ws + WS_XBA); h16* XBB = (h16*)(ws + WS_XBB);
    h16* U = (h16*)(ws + WS_U); float* XF = (float*)(ws + WS_XF); float* Y = ap->out;
    float* STATS = (float*)(ws + WS_STATS); float* CVEC = (float*)(ws + WS_CVEC);
    h16* CQ = (h16*)(ws + WS_CQ); h16* CKV = (h16*)(ws + WS_CKV); h16* QA = (h16*)(ws + WS_QA); h16* KA = (h16*)(ws + WS_KA); h16* VAT = (h16*)(ws + WS_VAT);
    h16* QB = (h16*)(ws + WS_QB); h16* KB = (h16*)(ws + WS_KB); h16* VBT = (h16*)(ws + WS_VBT); h16* OCAT = (h16*)(ws + WS_OCAT);
    h16* Q1 = (h16*)(ws + WS_Q1); h16* K1 = (h16*)(ws + WS_K1); h16* VT1 = (h16*)(ws + WS_VT1);
        int q = p, L = 0;
        if (p >= 12) { q = p - 8; L = 1; }
        if (PH_EN(0) && p == 0) {
            int tid0 = wave_id * 64 + lane_id_opaque(); asm volatile("" : "+v"(tid0));
            int gthreads = G * 512; asm volatile("" : "+s"(gthreads));
            const int gtid = cid * 512 + tid0;
            { const float* w = ap->in[2];
              prep_w(lds, WINA, NIN_A, 1024, 2080, nullptr, [=](int n) -> const float* { return n < 1536 ? w + 544 + n : n < 2048 ? w + (n - 1536) : n < 2080 ? w + 512 + (n - 2048) : nullptr; }, cid, G, tid0); }
            { const float* w = ap->in[4]; prep_w(lds, WUQ, 768, 256, 768, ap->in[3], [=](int n) -> const float* { return w + n; }, cid, G, tid0); }
            { const float* w = ap->in[6]; prep_w(lds, WUKV, 1024, 256, 1024, ap->in[5], [=](int n) -> const float* { return w + n; }, cid, G, tid0); }
            { const float* w = ap->in[7]; prep_w(lds, WOUTA, 1024, 1024, 1024, nullptr, [=](int n) -> const float* { return w + n; }, cid, G, tid0); }
            { const float* w = ap->in[8]; prep_w(lds, WINC, NIN_C, 1024, 3088, nullptr, [=](int n) -> const float* { return n < 3088 ? w + n : nullptr; }, cid, G, tid0); }
            { const float* w = ap->in[10]; prep_w(lds, WOUTC, 1024, 1024, 1024, nullptr, [=](int n) -> const float* { return w + n; }, cid, G, tid0); }
            for (int l = 0; l < 2; ++l) {
                { const float* w1 = ap->in[11] + (size_t)l * 1024 * DFF; const float* w3 = ap->in[12] + (size_t)l * 1024 * DFF;
                  prep_w(lds, W13 + (size_t)l * 5632 * 1024, 5632, 1024, DFF, ap->in[14] + l * DM, [=](int n) -> const float* { const int tl = n >> 8, r = n & 255; return w1 + (r < 128 ? (ptrdiff_t)0 : (w3 - w1)) + tl * 128 + (r & 127); }, cid, G, tid0,
                         CVEC + (size_t)(l * 2) * CV_N, CVEC + (size_t)(l * 2 + 1) * CV_N, ap->in[15] + l * DM); }
                { const float* w = ap->in[13] + (size_t)l * DFF * 1024; prep_w(lds, W2 + (size_t)l * 1024 * DFF, 1024, DFF, 1024, nullptr, [=](int n) -> const float* { return w + n; }, cid, G, tid0); }
                { const float* w = ap->in[19] + (size_t)l * 1024 * 1024; prep_w(lds, WG + (size_t)l * 1024 * 1024, 1024, 1024, 1024, ap->in[16] + l * DM, [=](int n) -> const float* { return w + n; }, cid, G, tid0,
                         CVEC + (size_t)(l * 2) * CV_N + 5632, CVEC + (size_t)(l * 2 + 1) * CV_N + 5632, ap->in[17] + l * DM); }
                { const float* w = ap->in[18] + (size_t)l * 256 * 1024; prep_w(lds, WP + (size_t)l * 1024 * 256, 1024, 256, 1024, nullptr, [=](int n) -> const float* { return w + n; }, cid, G, tid0); }
            }
            cvt_rows(XBA, ap->in[0], (size_t)T * DM / 8, gtid, gthreads);
            cvt_rows(PB, ap->in[1], (size_t)2 * T * PD / 8, gtid, gthreads);
            { float zf = 0.f; asm volatile("" : "+v"(zf)); for (int i = gtid; i < T * 2; i += gthreads) SSQ[i] = zf; }
            for (int i = gtid; i < SEQ * 16; i += gthreads) {
                const int pos = i >> 4, fi = i & 15;
                double invd = 1.0;
#pragma unroll 1
                for (int e = 0; e < fi; ++e) invd *= 0.56234132519034907;
                const float inv = (float)invd;
                const float ang = (float)pos * inv;
                const double ad = (double)ang, k = rint(ad * 0.15915494309189535);
                const double r = (ad - k * 6.283185307179586) - k * 2.4492935982947064e-16;
                double sn, cs; sincos_d(r, sn, cs);
                ROPE[2 * i] = (float)cs; ROPE[2 * i + 1] = (float)sn;
            }
        } else if (PH_EN(1) && p == 1) {
            pg8::Gemm g{XBA, WINA, T, NIN_A, 1024}; pg8::StaticOrder S; S.init(T, NIN_A, G, cid);
            EpiInA E{QB, KB, VBT, CQ, CKV, KA, SSQ, ROPE};
            pg8::gemm_phase(lds, g, S, E, wave_id);
        } else if (PH_EN(2) && p == 2) {
            { pg8::Gemm g{CQ, WUQ, T, 768, 256}; pg8::StaticOrder S; S.init(T, 768, G, cid); EpiUq E{QA, SSQ, ROPE}; pg8::gemm_phase(lds, g, S, E, wave_id); }
            { pg8::Gemm g{CKV, WUKV, T, 1024, 256}; pg8::StaticOrder S; S.init(T, 1024, G, cid); EpiUkv E{KA, VAT, SSQ}; pg8::gemm_phase(lds, g, S, E, wave_id); }
        } else if (PH_EN(3) && p == 3) {
            for (int r = 0;; ++r) {
                const int u = r * G + ((r & 1) ? G - 1 - cid : cid);
                if (u >= 2048) break;
                const int qb = 15 - (u >> 7), sub = u & 127, bh = sub & 63, b = bh >> 3, h = bh & 7;
#ifndef P3_SKIP
#define P3_SKIP 9
#endif
                if (P3_SKIP != 1 && sub < 64) attn_unit<1>(lds, QB, KB, VBT, OCAT, 512 + h * 64, nullptr, b, bh, qb, wave_id);
                else if (P3_SKIP != 0) attn_unit<0>(lds, QA, KA, VAT, OCAT, h * 64, nullptr, b, bh, qb, wave_id);
            }
        } else if (PH_EN(10) && p == 10) {
            pg8::Gemm g{XBB, WINC, T, NIN_C, 1024}; pg8::StaticOrder S; S.init(T, NIN_C, G, cid);
            EpiInC E{Q1, K1, VT1, FLT, ap->in[9]};
            pg8::gemm_phase(lds, g, S, E, wave_id);
        } else if (PH_EN(11) && p == 11) {
            for (int r = 0;; ++r) {
                const int u = r * G + ((r & 1) ? G - 1 - cid : cid);
                if (u >= 2048) break;
                const int qb = 15 - (u >> 7), bh = u & 127, b = bh >> 4, h = bh & 15;
                attn_unit<2>(lds, Q1, K1, VT1, OCAT, h * 64, FLT, b, bh, qb, wave_id);
            }
        } else if (PH_EN(4) && (q == 4 || q == 7)) {
            pg8::Gemm g; EpiResLn E;
            if (q == 4) { g = pg8::Gemm{OCAT, L ? WOUTC : WOUTA, T, DM, 1024};
                          E = EpiResLn{L ? XBB : XBA, nullptr, nullptr, nullptr, nullptr, XBA, STATS + (size_t)(L * 2) * T * 2}; }
            else { g = pg8::Gemm{U, W2 + (size_t)L * 1024 * DFF, T, DM, DFF};
                   E = EpiResLn{nullptr, XBA, STATS + (size_t)(L * 2) * T * 2, ap->in[14] + L * DM, ap->in[15] + L * DM, XBA, STATS + (size_t)(L * 2 + 1) * T * 2}; }
            pg8::StaticOrder S; S.init(T, DM, G, cid);
            pg8::gemm_phase(lds, g, S, E, wave_id);
        } else if (q == 5 || q == 8) {
            continue;
        } else if (PH_EN(6) && q == 6) {
            pg8::Gemm g{XBA, W13 + (size_t)L * 5632 * 1024, T, 5632, 1024}; pg8::StaticOrder S; S.init(T, 5632, G, cid);
            EpiSwiglu E{U, STATS + (size_t)(L * 2) * T * 2, CVEC + (size_t)(L * 2) * CV_N, CVEC + (size_t)(L * 2 + 1) * CV_N};
            pg8::gemm_phase(lds, g, S, E, wave_id);
        } else if (PH_EN(9) && q == 9) {
            pg8::StaticOrder S; S.init(T, DM, G, cid);
            { pg8::Gemm g{PB + (size_t)L * T * PD, WP + (size_t)L * 1024 * 256, T, DM, 256}; EpiStoreF32 E{(h16*)(ws + WS_Q1)}; pg8::gemm_phase(lds, g, S, E, wave_id); }
            { pg8::Gemm g{XBA, WG + (size_t)L * 1024 * 1024, T, DM, 1024};
              EpiPle E{XBA, STATS + (size_t)(L * 2 + 1) * T * 2, ap->in[16] + L * DM, ap->in[17] + L * DM, CVEC + (size_t)(L * 2) * CV_N + 5632, CVEC + (size_t)(L * 2 + 1) * CV_N + 5632, Y, ap->in[20] + L * DM, L ? nullptr : XBB, (const h16*)(ws + WS_Q1)};
              pg8::gemm_phase(lds, g, S, E, wave_id); }
        }
        if (pp + 1 < a.ph_hi * 2) grid_barrier((unsigned*)(ws + WS_BAR), bar_st, (unsigned)G, wave_id);
    }
}

extern "C" void kernel_launch(void* const* d_in, const int* in_sizes, int n_in, void* d_out, int out_size, void* d_ws, size_t ws_size, hipStream_t stream) {
    static int grid = 0;
    if (grid == 0) {
        if (n_in != 21 || out_size != T * DM || ws_size < WS_END) { fprintf(stderr, "kernel_launch: unexpected problem (n_in %d, out %d, ws %zu)\n", n_in, out_size, ws_size); grid = -1; return; }
        int dev = 0, cus = 0, per_cu = 0;
        hipGetDevice(&dev); hipDeviceGetAttribute(&cus, hipDeviceAttributeMultiprocessorCount, dev);
        if (hipFuncSetAttribute((const void*)mega, hipFuncAttributeMaxDynamicSharedMemorySize, LDS_BYTES) != hipSuccess) { fprintf(stderr, "kernel_launch: hipFuncSetAttribute failed\n"); grid = -1; return; }
        if (hipOccupancyMaxActiveBlocksPerMultiprocessor(&per_cu, (const void*)mega, 512, LDS_BYTES) != hipSuccess || per_cu < 1) { fprintf(stderr, "kernel_launch: occupancy query says %d\n", per_cu); per_cu = 1; }
        (void)hipGetLastError();
        grid = cus;
        fprintf(stderr, "kernel_launch: grid %d (per_cu %d)\n", grid, per_cu);
    }
    if (grid < 0) return;
    Args a{};
    for (int i = 0; i < 21; ++i) a.in[i] = (const float*)d_in[i];
    a.out = (float*)d_out; a.ws = (unsigned char*)d_ws;
#if MK_ONE_LAUNCH
    (void)hipMemsetAsync((char*)d_ws + WS_BAR, 0, 16384, stream);
    (void)hipMemsetAsync((char*)d_ws + WS_STATS, 0, WS_ZERO_BYTES, stream);
    a.ph_lo = 0; a.ph_hi = NPHASE;
    void* args[] = {&a};
    hipError_t e = hipLaunchCooperativeKernel((const void*)mega, dim3(grid), dim3(512), args, LDS_BYTES, stream);
    if (e != hipSuccess) fprintf(stderr, "cooperative launch failed: %s (grid %d)\n", hipGetErrorString(e), grid);
#else
    for (int p = 0; p < NPHASE; ++p) {
        a.ph_lo = p; a.ph_hi = p + 1;
        hipLaunchKernelGGL(mega, dim3(grid), dim3(512), LDS_BYTES, stream, a);
    }
#endif
}
```

```cpp
#include <hip/hip_runtime.h>
#include <hip/hip_cooperative_groups.h>
#include <cstdio>
#include <cstdint>
#include <type_traits>
namespace cg = cooperative_groups;

#define LAS __attribute__((address_space(3)))
typedef _Float16 h16;
typedef _Float16 h16x2 __attribute__((ext_vector_type(2)));
typedef _Float16 h16x4 __attribute__((ext_vector_type(4)));
typedef _Float16 h16x8 __attribute__((ext_vector_type(8)));
typedef float f32x2 __attribute__((ext_vector_type(2)));
typedef float f32x4 __attribute__((ext_vector_type(4)));
typedef float f32x16 __attribute__((ext_vector_type(16)));
typedef unsigned u32x2 __attribute__((ext_vector_type(2)));
typedef unsigned u32x4 __attribute__((ext_vector_type(4)));

#ifndef MK_ONE_LAUNCH
#define MK_ONE_LAUNCH 1
#endif

constexpr int SEQ = 4096, NB = 8, T = NB * SEQ, DM = 1024, DFF = 2816, PD = 256;
constexpr int NIN_A = 2304;
constexpr int NIN_C = 3328;
constexpr float ALPHA = 1.41421356237309515f;
constexpr float LOG2E = 1.44269504088896341f;
constexpr float QS_MLA = 0.10206207261596575f * LOG2E;
constexpr float QS_64 = 0.125f * LOG2E;
constexpr int NPHASE = 18;
#ifndef PH_MASK
#define PH_MASK 0xFFFFF
#endif
#define PH_EN(k) ((PH_MASK >> (k)) & 1)

constexpr size_t MiB = 1u << 20;
constexpr size_t WS_SSQ = 0;
constexpr size_t WS_BAR = 384 * 1024;
constexpr size_t WS_ROPE = 512 * 1024;
constexpr size_t WS_WINA = 1 * MiB;
constexpr size_t WS_WUQ = WS_WINA + (size_t)NIN_A * 1024 * 2;
constexpr size_t WS_WUKV = WS_WUQ + 768 * 256 * 2;
constexpr size_t WS_WOUTA = WS_WUKV + 1024 * 256 * 2;
constexpr size_t WS_WINC = WS_WOUTA + 1024 * 1024 * 2;
constexpr size_t WS_WOUTC = WS_WINC + (size_t)NIN_C * 1024 * 2;
constexpr size_t WS_W13 = WS_WOUTC + 1024 * 1024 * 2;
constexpr size_t WS_W2 = WS_W13 + (size_t)2 * 5632 * 1024 * 2;
constexpr size_t WS_WG = WS_W2 + (size_t)2 * 1024 * 2816 * 2;
constexpr size_t WS_WP = WS_WG + (size_t)2 * 1024 * 1024 * 2;
constexpr size_t WS_WEND = WS_WP + (size_t)2 * 1024 * 256 * 2;
static_assert(WS_WEND <= 62 * MiB, "weights region");
constexpr size_t WS_STATS = 56 * MiB;
constexpr size_t WS_CVEC = 57 * MiB;
constexpr size_t WS_ZERO_BYTES = 1 * MiB + 128 * 1024;
constexpr int CV_N = 6656;
static_assert(WS_WEND <= WS_STATS, "weights vs stats");
constexpr size_t WS_FLT = 62 * MiB;
constexpr size_t WS_PB = 64 * MiB;
constexpr size_t WS_XBA = 96 * MiB;
constexpr size_t WS_R1 = 160 * MiB;
constexpr size_t WS_U = WS_R1;
constexpr size_t WS_XBB = WS_R1;
constexpr size_t WS_XF = WS_R1 + 176 * MiB;
constexpr size_t WS_CQ = WS_R1, WS_CKV = WS_R1 + 16 * MiB, WS_QA = WS_R1 + 32 * MiB, WS_KA = WS_R1 + 80 * MiB, WS_VAT = WS_R1 + 128 * MiB;
constexpr size_t WS_QB = WS_R1 + 160 * MiB, WS_KB = WS_R1 + 192 * MiB, WS_VBT = WS_R1 + 224 * MiB, WS_OCAT = WS_R1 + 256 * MiB;
constexpr size_t WS_Q1 = WS_R1 + 64 * MiB, WS_K1 = WS_R1 + 128 * MiB, WS_VT1 = WS_R1 + 192 * MiB;
constexpr size_t WS_END = WS_R1 + 320 * MiB;

constexpr int LDS_BYTES = 131072 + 1024;

__device__ __forceinline__ int lane_id_opaque() { unsigned z = 0u; asm volatile("" : "+v"(z)); return (int)__builtin_amdgcn_mbcnt_hi(~0u, __builtin_amdgcn_mbcnt_lo(~0u, z)); }
namespace pg8 {
constexpr int BM = 256, BK = 64, HALF = 128, HTB = HALF * BK * 2, NXCD = 8, WGM = 8;
__host__ __device__ __forceinline__ int lds_byte(int r, int c) { const int st = (r >> 4) * 2 + (c >> 5), rr = r & 15, cc = c & 31, ob = rr * 64 + cc * 2; return st * 1024 + (ob ^ (((ob >> 9) & 1) << 5)); }
__host__ __device__ __forceinline__ void stage_rc(int b, int& R, int& C) { const int st = b / 1024, sb = b % 1024, swz = sb ^ (((sb >> 9) & 1) << 5); R = (st >> 1) * 16 + swz / 64; C = (st & 1) * 32 + (swz % 64) / 2; }
__host__ __device__ __forceinline__ int perm32(int rho) { const int n = rho >> 4, i = rho & 15; return 8 * (i >> 2) + 4 * n + (i & 3); }

struct Unit { int pm, pn; };
struct Gemm { const h16* A; const h16* Bt; int M, N, K; };

struct StaticOrder {
    int nM, nN, nwg, G, c;
    __device__ void init(int M, int N, int G_, int c_) { nM = M / BM; nN = N / BM; nwg = nM * nN; G = G_; c = c_; }
    __device__ bool next(int i, Unit& u) const {
        const long L = (long)i * G + c; if (L >= nwg) return false;
        int wgid = (int)L; { const int q = nwg / NXCD, r = nwg % NXCD, xcd = wgid % NXCD, off = wgid / NXCD; wgid = (xcd < r ? xcd * (q + 1) : r * (q + 1) + (xcd - r) * q) + off; }
        const int nig = WGM * nN, gid = wgid / nig, fm = gid * WGM, gsz = (nM - fm) < WGM ? (nM - fm) : WGM;
        u.pm = fm + ((wgid % nig) % gsz); u.pn = (wgid % nig) / gsz; return true;
    }
};

template <class Epi, class Sched, bool ALIGN_EPI = true, bool SP2 = true>
__device__ __forceinline__ void gemm_phase(LAS unsigned char* lds, const Gemm g, const Sched& S, const Epi& E, int wave_id) {
    int lane_ = lane_id_opaque(); asm volatile("" : "+v"(lane_));
    const int wid = wave_id, lane = lane_, tid = wid * 64 + lane, wr = wid >> 2, wc = wid & 3, fr = lane & 15, fq = lane >> 4;
    const int K = g.K, nt = K / BK;
    unsigned voffA[2], voffB[2];
#pragma unroll
    for (int i = 0; i < 2; ++i) { int R, C; stage_rc(tid * 16 + i * 8192, R, C); const int Rb = Epi::PERM ? ((R & ~31) + perm32(R & 31)) : R;
        voffA[i] = (unsigned)(R * K + C) * 2u; voffB[i] = (unsigned)(Rb * K + C) * 2u; }
    const size_t kstep = (size_t)(BK * 2);
    const size_t hstep = (size_t)HALF * K * 2;
    const size_t tstep = 2 * hstep;
    const unsigned ldsw = (unsigned)wid * 1024u;
    const int aoff = lds_byte(wr * 64 + fr, fq * 8), boff = lds_byte(wc * 32 + fr, fq * 8);
#define PG8_SA(b, h) (((b) * 2 + (h)) * HTB)
#define PG8_SB(b, h) ((4 + (b) * 2 + (h)) * HTB)
#define PG8_STAGE(bufoff, gbase, voff) do { _Pragma("unroll") for (int _i = 0; _i < 2; ++_i) \
        __builtin_amdgcn_global_load_lds((const unsigned*)((const char*)(gbase) + (voff)[_i]), (LAS unsigned*)(lds + (bufoff) + ldsw + _i * 8192), 16, 0, 0); } while (0)
#define PG8_LDA(dst, b, h) do { _Pragma("unroll") for (int m = 0; m < 4; ++m) _Pragma("unroll") for (int k = 0; k < 2; ++k) dst[m][k] = *(const LAS h16x8*)(lds + PG8_SA(b, h) + aoff + m * 2048 + k * 1024); } while (0)
#define PG8_LDB(dst, b, h) do { _Pragma("unroll") for (int n = 0; n < 2; ++n) _Pragma("unroll") for (int k = 0; k < 2; ++k) dst[n][k] = *(const LAS h16x8*)(lds + PG8_SB(b, h) + boff + n * 2048 + k * 1024); } while (0)
#define PG8_MMA(ai, bj, At, Bt) do { __builtin_amdgcn_s_setprio(1); _Pragma("unroll") for (int m = 0; m < 4; ++m) _Pragma("unroll") for (int n = 0; n < 2; ++n) _Pragma("unroll") for (int k = 0; k < 2; ++k) \
        acc[ai][bj][m][n] = __builtin_amdgcn_mfma_f32_16x16x32_f16(Bt[n][k], At[m][k], acc[ai][bj][m][n], 0, 0, 0); __builtin_amdgcn_s_setprio(0); } while (0)
#define PG8_WAIT_V(n) asm volatile("s_waitcnt vmcnt(" #n ")" ::: "memory")
#define PG8_WAIT_L(n) asm volatile("s_waitcnt lgkmcnt(" #n ")" ::: "memory")
#define PG8_BAR __builtin_amdgcn_s_barrier()
#define PG8_SCHED __builtin_amdgcn_sched_barrier(0)
    Unit cur, nxt; int ui = 0;
    if (!S.next(0, cur)) return;
    f32x4 acc[2][2][4][2];
#pragma unroll
    for (int a = 0; a < 2; ++a)
#pragma unroll
        for (int b = 0; b < 2; ++b)
#pragma unroll
            for (int m = 0; m < 4; ++m)
#pragma unroll
                for (int n = 0; n < 2; ++n) acc[a][b][m][n] = (f32x4){0.f, 0.f, 0.f, 0.f};
    h16x8 At[4][2], B0[2][2], B1[2][2];
    const char* cA = (const char*)g.A + (size_t)cur.pm * tstep; const char* cB = (const char*)g.Bt + (size_t)cur.pn * tstep;
    if constexpr (SP2) {
        PG8_STAGE(PG8_SB(0, 0), cB, voffB); PG8_STAGE(PG8_SB(0, 1), cB + hstep, voffB); PG8_STAGE(PG8_SA(0, 0), cA, voffA); PG8_STAGE(PG8_SA(0, 1), cA + hstep, voffA);
        if (wr == 1) PG8_BAR;
        PG8_WAIT_V(2); PG8_BAR;
        PG8_STAGE(PG8_SB(1, 0), cB + kstep, voffB); PG8_STAGE(PG8_SA(1, 0), cA + kstep, voffA); PG8_STAGE(PG8_SB(1, 1), cB + hstep + kstep, voffB);
        PG8_WAIT_V(6); PG8_BAR;
    } else {
        PG8_STAGE(PG8_SB(0, 0), cB, voffB); PG8_STAGE(PG8_SA(0, 0), cA, voffA); PG8_STAGE(PG8_SB(0, 1), cB + hstep, voffB); PG8_STAGE(PG8_SA(0, 1), cA + hstep, voffA);
        if (wr == 1) PG8_BAR;
        PG8_WAIT_V(4); PG8_BAR;
        PG8_STAGE(PG8_SB(1, 0), cB + kstep, voffB); PG8_STAGE(PG8_SA(1, 0), cA + kstep, voffA); PG8_STAGE(PG8_SB(1, 1), cB + hstep + kstep, voffB);
        PG8_WAIT_V(6); PG8_BAR;
    }
    for (;;) {
        const bool has_next = S.next(ui + 1, nxt);
        const char* nA = has_next ? (const char*)g.A + (size_t)nxt.pm * tstep : cA; const char* nB = has_next ? (const char*)g.Bt + (size_t)nxt.pn * tstep : cB;
        for (int t = 0; t < nt; t += 2) {
            const bool last = (t == nt - 2);
            const char* a1 = cA + (size_t)(t + 1) * kstep;
            const char* a2 = last ? nA : cA + (size_t)(t + 2) * kstep; const char* b2 = last ? nB : cB + (size_t)(t + 2) * kstep;
            const char* a3 = a2 + kstep; const char* b3 = b2 + kstep;
            if constexpr (SP2) {
            PG8_LDB(B0, 0, 0); PG8_LDB(B1, 0, 1); PG8_SCHED; PG8_LDA(At, 0, 0); PG8_STAGE(PG8_SA(1, 1), a1 + hstep, voffA);
            PG8_WAIT_V(8); PG8_WAIT_L(0); PG8_BAR; PG8_MMA(0, 0, At, B0); PG8_MMA(0, 1, At, B1); PG8_BAR; PG8_SCHED;
            PG8_LDA(At, 0, 1); PG8_STAGE(PG8_SB(0, 0), b2, voffB); PG8_STAGE(PG8_SB(0, 1), b2 + hstep, voffB); PG8_STAGE(PG8_SA(0, 0), a2, voffA);
            PG8_WAIT_V(8); PG8_WAIT_L(0); PG8_BAR; PG8_MMA(1, 0, At, B0); PG8_MMA(1, 1, At, B1); PG8_BAR; PG8_SCHED;
            PG8_LDB(B0, 1, 0); PG8_LDB(B1, 1, 1); PG8_SCHED; PG8_LDA(At, 1, 0); PG8_STAGE(PG8_SA(0, 1), a2 + hstep, voffA);
            PG8_WAIT_V(8); PG8_WAIT_L(0); PG8_BAR; PG8_MMA(0, 0, At, B0); PG8_MMA(0, 1, At, B1); PG8_BAR; PG8_SCHED;
            PG8_LDA(At, 1, 1); PG8_STAGE(PG8_SB(1, 0), b3, voffB); PG8_STAGE(PG8_SB(1, 1), b3 + hstep, voffB); PG8_STAGE(PG8_SA(1, 0), a3, voffA);
            PG8_WAIT_V(8); PG8_WAIT_L(0); PG8_BAR; PG8_MMA(1, 0, At, B0); PG8_MMA(1, 1, At, B1); PG8_BAR; PG8_SCHED;
            } else {
            PG8_LDB(B0, 0, 0); PG8_SCHED; PG8_LDA(At, 0, 0); PG8_STAGE(PG8_SA(1, 1), a1 + hstep, voffA);
            PG8_WAIT_L(8); PG8_BAR; PG8_WAIT_L(0); PG8_MMA(0, 0, At, B0); PG8_BAR; PG8_SCHED;
            PG8_LDB(B1, 0, 1); PG8_STAGE(PG8_SB(0, 0), b2, voffB);
            PG8_BAR; PG8_WAIT_L(0); PG8_MMA(0, 1, At, B1); PG8_BAR;
            PG8_LDA(At, 0, 1); PG8_STAGE(PG8_SA(0, 0), a2, voffA);
            PG8_BAR; PG8_WAIT_L(0); PG8_MMA(1, 0, At, B0); PG8_BAR; PG8_SCHED;
            PG8_STAGE(PG8_SB(0, 1), b2 + hstep, voffB);
            PG8_WAIT_V(6); PG8_BAR; PG8_MMA(1, 1, At, B1); PG8_BAR;
            PG8_LDB(B0, 1, 0); PG8_SCHED; PG8_LDA(At, 1, 0); PG8_STAGE(PG8_SA(0, 1), a2 + hstep, voffA);
            PG8_WAIT_L(8); PG8_BAR; PG8_WAIT_L(0); PG8_MMA(0, 0, At, B0); PG8_BAR; PG8_SCHED;
            PG8_LDB(B1, 1, 1); PG8_STAGE(PG8_SB(1, 0), b3, voffB);
            PG8_BAR; PG8_WAIT_L(0); PG8_MMA(0, 1, At, B1); PG8_BAR;
            PG8_LDA(At, 1, 1); PG8_STAGE(PG8_SA(1, 0), a3, voffA);
            PG8_BAR; PG8_WAIT_L(0); PG8_MMA(1, 0, At, B0); PG8_BAR; PG8_SCHED;
            PG8_STAGE(PG8_SB(1, 1), b3 + hstep, voffB);
            PG8_WAIT_V(6); PG8_BAR; PG8_MMA(1, 1, At, B1); PG8_BAR;
            }
        }
        if constexpr (ALIGN_EPI) { if (wr == 0) PG8_BAR; }
        { const int ln_ = lane_id_opaque(); int fr_ = ln_ & 15, fq_ = ln_ >> 4; asm volatile("" : "+v"(fr_), "+v"(fq_));
          E(acc, cur, wr, wc, fr_, fq_); }
        if (!has_next) break;
#pragma unroll
        for (int a = 0; a < 2; ++a)
#pragma unroll
            for (int b = 0; b < 2; ++b)
#pragma unroll
                for (int m = 0; m < 4; ++m)
#pragma unroll
                    for (int n = 0; n < 2; ++n) acc[a][b][m][n] = (f32x4){0.f, 0.f, 0.f, 0.f};
        cur = nxt; cA = nA; cB = nB; ++ui;
        if constexpr (ALIGN_EPI) { if (wr == 1) PG8_BAR; }
    }
    PG8_WAIT_V(0);
    if constexpr (!ALIGN_EPI) { if (wr == 0) PG8_BAR; }
    PG8_BAR;
#undef PG8_SA
#undef PG8_SB
#undef PG8_STAGE
#undef PG8_LDA
#undef PG8_LDB
#undef PG8_MMA
#undef PG8_WAIT_V
#undef PG8_WAIT_L
#undef PG8_BAR
#undef PG8_SCHED
}
}

typedef float acc_t[2][2][4][2][4];
using pg8::Unit;
#define ACC_ARG const f32x4 (&acc)[2][2][4][2]

__device__ __forceinline__ float shx(float x, int mask, int lane) { return __builtin_bit_cast(float, __builtin_amdgcn_ds_bpermute((lane ^ mask) << 2, __builtin_bit_cast(int, x))); }
__device__ __forceinline__ float shup(float x, int off, int lane) { return __builtin_bit_cast(float, __builtin_amdgcn_ds_bpermute((lane - off) << 2, __builtin_bit_cast(int, x))); }
__device__ __forceinline__ unsigned pk2(float a, float b) { h16x2 v; v.x = (h16)a; v.y = (h16)b; return __builtin_bit_cast(unsigned, v); }
__device__ __forceinline__ u32x2 pk4(f32x4 v) { u32x2 r; r.x = pk2(v[0], v[1]); r.y = pk2(v[2], v[3]); return r; }
__device__ __forceinline__ unsigned pk2z(float a, float b) { return __builtin_bit_cast(unsigned, __builtin_amdgcn_cvt_pkrtz(a, b)); }

struct EpiInA {
    static constexpr bool PERM = false;
    h16 *QB, *KB, *VBT, *CQ, *CKV, *KA; float* SSQ; const float* ROPE;
    __device__ __forceinline__ void operator()(ACC_ARG, const Unit& u, int wr, int wc, int fr, int fq) const {
        const int pn = u.pn;
        if (pn == 8 && wc != 0) return;
#pragma unroll
        for (int ai = 0; ai < 2; ++ai)
#pragma unroll
            for (int m = 0; m < 4; ++m) {
                const int row = u.pm * 256 + ai * 128 + wr * 64 + m * 16 + fr, b = row >> 12, s = row & 4095;
                if (pn < 6) {
#pragma unroll
                    for (int bj = 0; bj < 2; ++bj)
#pragma unroll
                        for (int n = 0; n < 2; ++n) {
                            const int c = (pn & 1) * 256 + bj * 128 + wc * 32 + n * 16 + fq * 4, head = c >> 6, d = c & 63;
                            f32x4 v = acc[ai][bj][m][n];
                            if (pn < 2) { v = v * QS_64; *(u32x2*)(QB + ((size_t)(b * 8 + head) * SEQ + s) * 64 + d) = pk4(v); }
                            else if (pn < 4) { *(u32x2*)(KB + ((size_t)(b * 8 + head) * SEQ + s) * 64 + d) = pk4(v); }
                            else { h16* vp = VBT + ((size_t)(b * 8 + head) * 64 + (s >> 6)) * 4096 + (size_t)d * 64 + (s & 63);
#pragma unroll
                                for (int e = 0; e < 4; ++e) vp[e * 64] = (h16)v[e]; }
                        }
                } else if (pn < 8) {
                    h16* dst = (pn == 6 ? CQ : CKV) + (size_t)row * 256;
                    float ss = 0.f;
#pragma unroll
                    for (int bj = 0; bj < 2; ++bj)
#pragma unroll
                        for (int n = 0; n < 2; ++n) {
                            const f32x4 v = acc[ai][bj][m][n];
                            ss += (v[0] * v[0] + v[1] * v[1]) + (v[2] * v[2] + v[3] * v[3]);
                            *(u32x2*)(dst + bj * 128 + wc * 32 + n * 16 + fq * 4) = pk4(v);
                        }
                    { const int ln = fr + 16 * fq; ss += shx(ss, 16, ln); ss += shx(ss, 32, ln); }
                    if (fq == 0) atomicAdd(SSQ + (size_t)row * 2 + (pn - 6), ss);
                } else {
                    const f32x4 x1 = acc[ai][0][m][0], x2 = acc[ai][0][m][1];
                    const float* rp = ROPE + ((size_t)s * 16 + fq * 4) * 2;
                    const f32x4 cs0 = *(const f32x4*)rp, cs1 = *(const f32x4*)(rp + 4);
                    f32x4 o1, o2;
                    o1[0] = x1[0] * cs0[0] - x2[0] * cs0[1]; o2[0] = x1[0] * cs0[1] + x2[0] * cs0[0];
                    o1[1] = x1[1] * cs0[2] - x2[1] * cs0[3]; o2[1] = x1[1] * cs0[3] + x2[1] * cs0[2];
                    o1[2] = x1[2] * cs1[0] - x2[2] * cs1[1]; o2[2] = x1[2] * cs1[1] + x2[2] * cs1[0];
                    o1[3] = x1[3] * cs1[2] - x2[3] * cs1[3]; o2[3] = x1[3] * cs1[3] + x2[3] * cs1[2];
                    const u32x2 p1 = pk4(o1), p2 = pk4(o2);
#pragma unroll
                    for (int h = 0; h < 8; ++h) { h16* kp = KA + ((size_t)(b * 8 + h) * SEQ + s) * 96 + 64 + fq * 4; *(u32x2*)kp = p1; *(u32x2*)(kp + 16) = p2; }
                }
            }
    }
};

struct EpiUq {
    static constexpr bool PERM = false;
    h16* QA; const float* SSQ; const float* ROPE;
    __device__ __forceinline__ void operator()(ACC_ARG, const Unit& u, int wr, int wc, int fr, int fq) const {
        float ssv[2][4];
#pragma unroll
        for (int ai = 0; ai < 2; ++ai)
#pragma unroll
            for (int m = 0; m < 4; ++m) ssv[ai][m] = SSQ[(size_t)(u.pm * 256 + ai * 128 + wr * 64 + m * 16 + fr) * 2 + 0];
        __builtin_amdgcn_sched_barrier(0);
#pragma unroll
        for (int ai = 0; ai < 2; ++ai)
#pragma unroll
            for (int m = 0; m < 4; ++m) {
                const int row = u.pm * 256 + ai * 128 + wr * 64 + m * 16 + fr, b = row >> 12, s = row & 4095;
                const float rs = __builtin_amdgcn_rsqf(ssv[ai][m] * (1.f / 256.f) + 1e-6f) * QS_MLA;
#pragma unroll
                for (int bj = 0; bj < 2; ++bj) {
                    const int g32 = u.pn * 8 + bj * 4 + wc, head = g32 / 3, part = g32 - head * 3;
                    h16* qp = QA + ((size_t)(b * 8 + head) * SEQ + s) * 96;
                    if (part < 2) {
#pragma unroll
                        for (int n = 0; n < 2; ++n) *(u32x2*)(qp + part * 32 + n * 16 + fq * 4) = pk4(acc[ai][bj][m][n] * rs);
                    } else {
                        const f32x4 x1 = acc[ai][bj][m][0] * rs, x2 = acc[ai][bj][m][1] * rs;
                        const float* rp = ROPE + ((size_t)s * 16 + fq * 4) * 2;
                        const f32x4 cs0 = *(const f32x4*)rp, cs1 = *(const f32x4*)(rp + 4);
                        f32x4 o1, o2;
                        o1[0] = x1[0] * cs0[0] - x2[0] * cs0[1]; o2[0] = x1[0] * cs0[1] + x2[0] * cs0[0];
                        o1[1] = x1[1] * cs0[2] - x2[1] * cs0[3]; o2[1] = x1[1] * cs0[3] + x2[1] * cs0[2];
                        o1[2] = x1[2] * cs1[0] - x2[2] * cs1[1]; o2[2] = x1[2] * cs1[1] + x2[2] * cs1[0];
                        o1[3] = x1[3] * cs1[2] - x2[3] * cs1[3]; o2[3] = x1[3] * cs1[3] + x2[3] * cs1[2];
                        *(u32x2*)(qp + 64 + fq * 4) = pk4(o1); *(u32x2*)(qp + 80 + fq * 4) = pk4(o2);
                    }
                }
            }
    }
};

struct EpiUkv {
    static constexpr bool PERM = false;
    h16 *KA, *VAT; const float* SSQ;
    __device__ __forceinline__ void operator()(ACC_ARG, const Unit& u, int wr, int wc, int fr, int fq) const {
        float ssv[2][4];
#pragma unroll
        for (int ai = 0; ai < 2; ++ai)
#pragma unroll
            for (int m = 0; m < 4; ++m) ssv[ai][m] = SSQ[(size_t)(u.pm * 256 + ai * 128 + wr * 64 + m * 16 + fr) * 2 + 1];
        __builtin_amdgcn_sched_barrier(0);
#pragma unroll
        for (int ai = 0; ai < 2; ++ai)
#pragma unroll
            for (int m = 0; m < 4; ++m) {
                const int row = u.pm * 256 + ai * 128 + wr * 64 + m * 16 + fr, b = row >> 12, s = row & 4095;
                const float rs = __builtin_amdgcn_rsqf(ssv[ai][m] * (1.f / 256.f) + 1e-6f);
#pragma unroll
                for (int bj = 0; bj < 2; ++bj) {
                    const int head = u.pn * 2 + bj;
#pragma unroll
                    for (int n = 0; n < 2; ++n) {
                        const f32x4 v = acc[ai][bj][m][n] * rs;
                        const int e128 = wc * 32 + n * 16 + fq * 4;
                        if (wc < 2) *(u32x2*)(KA + ((size_t)(b * 8 + head) * SEQ + s) * 96 + e128) = pk4(v);
                        else { h16* vp = VAT + ((size_t)(b * 8 + head) * 64 + (s >> 6)) * 4096 + (size_t)(e128 - 64) * 64 + (s & 63);
#pragma unroll
                            for (int e = 0; e < 4; ++e) vp[e * 64] = (h16)v[e]; }
                    }
                }
            }
    }
};

__device__ __forceinline__ void ln_stats(const float* st, size_t row, float& mu, float& rs) {
    const f32x2 v = *(const f32x2*)(st + row * 2);
    mu = v.x * (1.f / 1024.f);
    const float var = fmaxf(v.y * (1.f / 1024.f) - mu * mu, 0.f);
    rs = __builtin_amdgcn_rsqf(var + 1e-5f);
}
struct EpiResLn {
    static constexpr bool PERM = true; static constexpr bool PREFETCH = false;
    const h16* X; const h16* XS; const float* st_in; const float* g_in; const float* b_in;
    h16* Yh; float* st_out;
    __device__ __forceinline__ void operator()(ACC_ARG, const Unit& u, int wr, int wc, int fr, int fq) const {
        const int ln = fr + 16 * fq;
        const h16* src = X ? X : XS;
        u32x4 xin[2][4]; f32x4 gg[2][2], bb[2][2];
        float sy[4], sq[4], mu[4], rs[4];
        auto loadq = [&](int b, int buf) {
            const int ai = b >> 1, bj = b & 1, col = u.pn * 256 + bj * 128 + wc * 32 + fq * 8;
            const size_t row0 = (size_t)(u.pm * 256 + ai * 128 + wr * 64 + fr);
#pragma unroll
            for (int m = 0; m < 4; ++m) xin[buf][m] = *(const u32x4*)(src + (row0 + 16 * m) * DM + col);
            if (!X) {
#pragma unroll
                for (int n = 0; n < 2; ++n) { gg[buf][n] = *(const f32x4*)(g_in + col + 4 * n); bb[buf][n] = *(const f32x4*)(b_in + col + 4 * n); }
            }
        };
        loadq(0, 0);
#pragma unroll
        for (int b = 0; b < 4; ++b) {
            const int ai = b >> 1, bj = b & 1, buf = b & 1, col = u.pn * 256 + bj * 128 + wc * 32 + fq * 8;
            const size_t row0 = (size_t)(u.pm * 256 + ai * 128 + wr * 64 + fr);
            if (bj == 0) {
#pragma unroll
                for (int m = 0; m < 4; ++m) { sy[m] = 0.f; sq[m] = 0.f; mu[m] = 0.f; rs[m] = 1.f; if (!X) ln_stats(st_in, row0 + 16 * m, mu[m], rs[m]); }
            }
            if (b + 1 < 4) loadq(b + 1, buf ^ 1);
            __builtin_amdgcn_sched_barrier(0);
#pragma unroll
            for (int m = 0; m < 4; ++m) {
                const h16x8 xh = __builtin_bit_cast(h16x8, xin[buf][m]); u32x4 w;
#pragma unroll
                for (int n = 0; n < 2; ++n) {
                    f32x4 x; x[0] = (float)xh[4 * n]; x[1] = (float)xh[4 * n + 1]; x[2] = (float)xh[4 * n + 2]; x[3] = (float)xh[4 * n + 3];
                    if (!X) x = (x - mu[m]) * rs[m] * gg[buf][n] + bb[buf][n];
                    const f32x4 y = x * ALPHA + acc[ai][bj][m][n];
                    sy[m] += (y[0] + y[1]) + (y[2] + y[3]); sq[m] += (y[0] * y[0] + y[1] * y[1]) + (y[2] * y[2] + y[3] * y[3]);
                    const u32x2 p = pk4(y); if (n == 0) { w.x = p.x; w.y = p.y; } else { w.z = p.x; w.w = p.y; }
                }
                *(u32x4*)(Yh + (row0 + 16 * m) * DM + col) = w;
            }
            if (bj == 1) {
#pragma unroll
                for (int m = 0; m < 4; ++m) {
                    float a = sy[m], c = sq[m];
                    a += shx(a, 16, ln); a += shx(a, 32, ln); c += shx(c, 16, ln); c += shx(c, 32, ln);
                    if (fq == 0) { atomicAdd(st_out + (row0 + 16 * m) * 2, a); atomicAdd(st_out + (row0 + 16 * m) * 2 + 1, c); }
                }
            }
        }
    }
};

struct EpiSwiglu {
    static constexpr bool PERM = true;
    h16* U; const float* st; const float* c1; const float* c2;
    __device__ __forceinline__ void operator()(ACC_ARG, const Unit& u, int wr, int wc, int fr, int fq) const {
        f32x4 k1[2][2], k2[2][2];
#pragma unroll
        for (int bj = 0; bj < 2; ++bj)
#pragma unroll
            for (int n = 0; n < 2; ++n) { const int nd = u.pn * 256 + bj * 128 + wc * 32 + fq * 8 + 4 * n; k1[bj][n] = *(const f32x4*)(c1 + nd); k2[bj][n] = *(const f32x4*)(c2 + nd); }
        float mus[2][4], rss[2][4];
#pragma unroll
        for (int ai = 0; ai < 2; ++ai)
#pragma unroll
            for (int m = 0; m < 4; ++m) ln_stats(st, (size_t)(u.pm * 256 + ai * 128 + wr * 64 + m * 16 + fr), mus[ai][m], rss[ai][m]);
#pragma unroll
        for (int ai = 0; ai < 2; ++ai)
#pragma unroll
            for (int m = 0; m < 4; ++m) {
                const size_t row = (size_t)(u.pm * 256 + ai * 128 + wr * 64 + m * 16 + fr);
                const float mu = mus[ai][m], rs = rss[ai][m];
                u32x4 w;
#pragma unroll
                for (int n = 0; n < 2; ++n) {
                    const f32x4 g = (acc[ai][0][m][n] - k1[0][n] * mu) * rs + k2[0][n], up = (acc[ai][1][m][n] - k1[1][n] * mu) * rs + k2[1][n]; f32x4 h;
#pragma unroll
                    for (int e = 0; e < 4; ++e) h[e] = g[e] * __builtin_amdgcn_rcpf(1.f + __builtin_amdgcn_exp2f(-g[e] * LOG2E)) * up[e];
                    const u32x2 p = pk4(h); if (n == 0) { w.x = p.x; w.y = p.y; } else { w.z = p.x; w.w = p.y; }
                }
                *(u32x4*)(U + row * DFF + u.pn * 128 + wc * 32 + fq * 8) = w;
            }
    }
};

struct EpiStoreF32 {
    static constexpr bool PERM = true;
    h16* P;
    __device__ __forceinline__ void operator()(ACC_ARG, const Unit& u, int wr, int wc, int fr, int fq) const {
#pragma unroll
        for (int ai = 0; ai < 2; ++ai)
#pragma unroll
            for (int m = 0; m < 4; ++m) {
                const size_t row = (size_t)(u.pm * 256 + ai * 128 + wr * 64 + m * 16 + fr);
#pragma unroll
                for (int bj = 0; bj < 2; ++bj) {
                    const size_t o = row * DM + u.pn * 256 + bj * 128 + wc * 32 + fq * 8;
                    const u32x2 p0 = pk4(acc[ai][bj][m][0]), p1 = pk4(acc[ai][bj][m][1]); u32x4 w; w.x = p0.x; w.y = p0.y; w.z = p1.x; w.w = p1.y;
                    *(u32x4*)(P + o) = w;
                }
            }
    }
};

struct EpiPle {
    static constexpr bool PERM = true;
    const h16* Y2; const float* st; const float* g2; const float* b2; const float* c1; const float* c2; float* Y; const float* bg; h16* XBo; const h16* PJ;
    __device__ __forceinline__ void operator()(ACC_ARG, const Unit& u, int wr, int wc, int fr, int fq) const {
        float mu[2][4], rs[2][4];
#pragma unroll
        for (int ai = 0; ai < 2; ++ai)
#pragma unroll
            for (int m = 0; m < 4; ++m) ln_stats(st, (size_t)(u.pm * 256 + ai * 128 + wr * 64 + m * 16 + fr), mu[ai][m], rs[ai][m]);
#pragma unroll
        for (int bj = 0; bj < 2; ++bj) {
            const int col = u.pn * 256 + bj * 128 + wc * 32 + fq * 8;
            f32x4 gg[2], b2v[2], k1[2], k2b[2];
#pragma unroll
            for (int n = 0; n < 2; ++n) { gg[n] = *(const f32x4*)(g2 + col + 4 * n); b2v[n] = *(const f32x4*)(b2 + col + 4 * n); k1[n] = *(const f32x4*)(c1 + col + 4 * n);
                                          k2b[n] = *(const f32x4*)(c2 + col + 4 * n) + *(const f32x4*)(bg + col + 4 * n); }
#pragma unroll
            for (int ai = 0; ai < 2; ++ai) {
#pragma unroll
              for (int mh = 0; mh < 2; ++mh) {
                u32x4 pin[4], yin[4];
#pragma unroll
                for (int m = 2 * mh; m < 2 * mh + 2; ++m) { const size_t o = (size_t)(u.pm * 256 + ai * 128 + wr * 64 + m * 16 + fr) * DM + col; pin[m] = *(const u32x4*)(PJ + o); yin[m] = *(const u32x4*)(Y2 + o); }
                __builtin_amdgcn_sched_barrier(0);
#pragma unroll
                for (int m = 2 * mh; m < 2 * mh + 2; ++m) {
                    const size_t o = (size_t)(u.pm * 256 + ai * 128 + wr * 64 + m * 16 + fr) * DM + col;
                    u32x4 w; const h16x8 pj = __builtin_bit_cast(h16x8, pin[m]), yh = __builtin_bit_cast(h16x8, yin[m]);
#pragma unroll
                    for (int n = 0; n < 2; ++n) {
                        f32x4 ys; ys[0] = (float)yh[4 * n]; ys[1] = (float)yh[4 * n + 1]; ys[2] = (float)yh[4 * n + 2]; ys[3] = (float)yh[4 * n + 3];
                        f32x4 pr; pr[0] = (float)pj[4 * n]; pr[1] = (float)pj[4 * n + 1]; pr[2] = (float)pj[4 * n + 2]; pr[3] = (float)pj[4 * n + 3];
                        const f32x4 x = (ys - mu[ai][m]) * rs[ai][m] * gg[n] + b2v[n];
                        const f32x4 z = (acc[ai][bj][m][n] - k1[n] * mu[ai][m]) * rs[ai][m] + k2b[n]; f32x4 r;
#pragma unroll
                        for (int e = 0; e < 4; ++e) r[e] = x[e] + __builtin_amdgcn_rcpf(1.f + __builtin_amdgcn_exp2f(-z[e] * LOG2E)) * pr[e];
                        if (!XBo) *(f32x4*)(Y + o + 4 * n) = r;
                        const u32x2 p = pk4(r); if (n == 0) { w.x = p.x; w.y = p.y; } else { w.z = p.x; w.w = p.y; }
                    }
                    if (XBo) *(u32x4*)(XBo + o) = w;
                }
              }
            }
        }
    }
};

struct EpiInC {
    static constexpr bool PERM = true;
    h16 *Q1, *K1, *VT1; float* FLT; const float* bf;
    __device__ __forceinline__ void operator()(ACC_ARG, const Unit& u, int wr, int wc, int fr, int fq) const {
        const int pn = u.pn;
        if (pn == 12 && (wc != 0 || fq >= 2)) return;
#pragma unroll
        for (int ai = 0; ai < 2; ++ai)
#pragma unroll
            for (int m = 0; m < 4; ++m) {
                const int row = u.pm * 256 + ai * 128 + wr * 64 + m * 16 + fr, b = row >> 12, s = row & 4095;
                if (pn < 12) {
#pragma unroll
                    for (int bj = 0; bj < 2; ++bj) {
                        const int head = (pn & 3) * 4 + bj * 2 + (wc >> 1), d = (wc & 1) * 32 + fq * 8;
                        f32x4 v0 = acc[ai][bj][m][0], v1 = acc[ai][bj][m][1];
                        if (pn < 8) {
                            if (pn < 4) { v0 = v0 * QS_64; v1 = v1 * QS_64; }
                            h16* dst = (pn < 4 ? Q1 : K1) + ((size_t)(b * 16 + head) * SEQ + s) * 64 + d;
                            const u32x2 p0 = pk4(v0), p1 = pk4(v1); u32x4 w; w.x = p0.x; w.y = p0.y; w.z = p1.x; w.w = p1.y;
                            *(u32x4*)dst = w;
                        } else {
                            h16* vp = VT1 + ((size_t)(b * 16 + head) * 64 + (s >> 6)) * 4096 + (size_t)d * 64 + (s & 63);
#pragma unroll
                            for (int e = 0; e < 4; ++e) { vp[e * 64] = (h16)v0[e]; vp[(4 + e) * 64] = (h16)v1[e]; }
                        }
                    }
                } else {
#pragma unroll
                    for (int n = 0; n < 2; ++n)
#pragma unroll
                        for (int e = 0; e < 4; ++e) {
                            const int hd = fq * 8 + n * 4 + e;
                            const float z = (acc[ai][0][m][n][e] + bf[hd]) * LOG2E;
                            const float ls = fminf(z, 0.f) - __builtin_amdgcn_logf(1.f + __builtin_amdgcn_exp2f(-fabsf(z)));
                            FLT[(size_t)(b * 16 + hd) * SEQ + s] = ls;
                        }
                }
            }
    }
};

constexpr int AT_KBYTES = 13312, AT_VOFF = 2 * AT_KBYTES, AT_VBYTES = 9216, AT_DCOFF = AT_VOFF + 2 * AT_VBYTES, AT_WSOFF = AT_DCOFF + 16384;
template <int MODE>
__device__ __forceinline__ void attn_unit(LAS unsigned char* lds, const h16* __restrict__ Qg, const h16* __restrict__ Kg, const h16* __restrict__ VTg,
                                          h16* __restrict__ Og, int ocol, const float* __restrict__ FLTg, int b, int bh, int qb, int wave_id) {
    constexpr int D = (MODE == 0) ? 96 : 64, KRS = (D + 8) * 2, VRS = 144, NDS = D / 16;
    constexpr float THR = 8.0f;
    int lane_ = lane_id_opaque(); asm volatile("" : "+v"(lane_));
    const int lane = lane_, w = wave_id, tid = w * 64 + lane, j = lane & 31, hh = lane >> 5;
    const int q0 = qb * 256, qw = q0 + 32 * w, nkt = 4 * qb + 4, kt_last = qw >> 6;
    const int it0 = nkt - 1 - kt_last;
    const int pij = (j & 0x13) | ((j & 4) << 1) | ((j & 8) >> 1);
    const int tqd = 32 * (w & 1) + j;
    LAS float* DC = (LAS float*)(lds + AT_DCOFF);
    asm volatile("s_waitcnt lgkmcnt(0)\n\ts_barrier" ::: "memory");
    h16x8 qf[NDS];
    { const h16* qrow = Qg + ((size_t)bh * SEQ + qw + j) * D + 8 * hh;
#pragma unroll
      for (int ds = 0; ds < NDS; ++ds) qf[ds] = *(const h16x8*)(qrow + 16 * ds); }
    const int srow = tid >> 3, sch = tid & 7;
    struct StageRegs { u32x4 k0, k1, v; };
    StageRegs RA, RB;
    const int koff0 = (MODE == 0) ? (tid / 12) * 96 + (tid % 12) * 8 : srow * 64 + sch * 8;
    const int koff1 = (MODE == 0) ? ((tid + 512) / 12) * 96 + ((tid + 512) % 12) * 8 : 0;
    const int voff = srow * 64 + sch * 8;
    auto gloadK = [&](int kt, StageRegs& r) {
        const h16* kbase = Kg + ((size_t)bh * SEQ + (size_t)kt * 64) * D;
        r.k0 = *(const u32x4*)(kbase + koff0);
        if constexpr (MODE == 0) { if (tid < 256) r.k1 = *(const u32x4*)(kbase + koff1); }
    };
    auto gloadV = [&](int kt, StageRegs& r) { const h16* vbase = VTg + ((size_t)bh * 64 + (size_t)kt) * 4096; r.v = *(const u32x4*)(vbase + voff); };
    auto lstoreK = [&](int buf, const StageRegs& r) {
        if constexpr (MODE == 0) {
            const int c0 = tid, r0 = c0 / 12, h0 = c0 - r0 * 12;
            *(LAS u32x4*)(lds + buf * AT_KBYTES + r0 * KRS + h0 * 16) = r.k0;
            if (tid < 256) { const int c1 = tid + 512, r1 = c1 / 12, h1 = c1 - r1 * 12; *(LAS u32x4*)(lds + buf * AT_KBYTES + r1 * KRS + h1 * 16) = r.k1; }
        } else {
            *(LAS u32x4*)(lds + buf * AT_KBYTES + srow * KRS + sch * 16) = r.k0;
        }
    };
    auto lstoreV = [&](int buf, const StageRegs& r) { *(LAS u32x4*)(lds + AT_VOFF + buf * AT_VBYTES + srow * VRS + sch * 16) = r.v; };
    auto lds_barrier = [&]() { asm volatile("s_waitcnt lgkmcnt(0)\n\ts_barrier" ::: "memory"); };
    gloadK(nkt - 1, RA); gloadV(nkt - 1, RA); gloadK(nkt - 2, RB);
    float dt = 0.f;
    if constexpr (MODE == 2) {
        const float* src = FLTg + (size_t)bh * SEQ + 8 * tid;
        const f32x4 a = *(const f32x4*)src, c = *(const f32x4*)(src + 4);
        float v[8] = {a[0], a[1], a[2], a[3], c[0], c[1], c[2], c[3]};
#pragma unroll
        for (int i = 1; i < 8; ++i) v[i] += v[i - 1];
        float x = v[7];
#pragma unroll
        for (int off = 1; off < 64; off <<= 1) { const float y = shup(x, off, lane); if (lane >= off) x += y; }
        LAS float* WS = (LAS float*)(lds + AT_WSOFF);
        if (lane == 63) WS[w] = x;
        asm volatile("s_waitcnt lgkmcnt(0)\n\ts_barrier" ::: "memory");
        float woff = 0.f;
#pragma unroll
        for (int i = 0; i < 8; ++i) { const float t = WS[i]; if (i < w) woff += t; }
        const float excl = x - v[7] + woff;
#pragma unroll
        for (int i = 0; i < 8; ++i) DC[8 * tid + i] = excl + v[i];
        asm volatile("s_waitcnt lgkmcnt(0)\n\ts_barrier" ::: "memory");
        dt = DC[qw + j];
    }
    f32x16 oacc[2];
#pragma unroll
    for (int i = 0; i < 16; ++i) { oacc[0][i] = 0.f; oacc[1][i] = 0.f; }
    float m_run = 0.f, R = (MODE == 1) ? 1.f : 0.f;
    f32x16 lacc;
#pragma unroll
    for (int i = 0; i < 16; ++i) lacc[i] = 0.f;
    h16x8 onesf;
#pragma unroll
    for (int i = 0; i < 8; ++i) onesf[i] = (j == 0) ? (h16)1.0f : (h16)0.0f;
    auto ST = [&](f32x16 (&s)[2], int it, auto diag_c) {
        constexpr bool DIAG = decltype(diag_c)::value;
        const int kt = nkt - 1 - it;
#pragma unroll
        for (int ks = 0; ks < 2; ++ks) {
            if constexpr (MODE == 2) {
                const float base = dt - m_run;
#pragma unroll
                for (int run = 0; run < 2; ++run) {
                    const LAS float* dk = DC + 64 * kt + 32 * ks + 16 * run + 8 * hh;
                    const f32x4 d0 = *(const LAS f32x4*)dk, d1 = *(const LAS f32x4*)(dk + 4);
#pragma unroll
                    for (int e = 0; e < 4; ++e) { s[ks][8 * run + e] = base - d0[e]; s[ks][8 * run + 4 + e] = base - d1[e]; }
                }
            } else {
                const float base = (MODE == 0) ? -m_run : 0.f;
#pragma unroll
                for (int r = 0; r < 16; ++r) s[ks][r] = base;
            }
            if constexpr (DIAG && MODE != 0) {
#pragma unroll
                for (int r = 0; r < 16; ++r) { const int kq = 32 * ks + 16 * (r >> 3) + 8 * hh + (r & 7); if (MODE == 1 ? (kq >= tqd) : (kq > tqd)) s[ks][r] = -1e30f; }
            }
            const LAS unsigned char* kb = lds + (it & 1) * AT_KBYTES + (32 * ks + pij) * KRS + hh * 16;
#pragma unroll
            for (int ds = 0; ds < NDS; ++ds) s[ks] = __builtin_amdgcn_mfma_f32_32x32x16_f16(*(const LAS h16x8*)(kb + ds * 32), qf[ds], s[ks], 0, 0, 0);
        }
    };
    auto BMAX = [&](f32x16 (&s)[2], bool first) {
        if constexpr (MODE != 1) {
            float tmx = fmaxf(s[0][0], s[1][0]);
#pragma unroll
            for (int r = 1; r < 16; ++r) tmx = fmaxf(tmx, fmaxf(s[0][r], s[1][r]));
            tmx = fmaxf(tmx, shx(tmx, 32, lane));
            if (first || __builtin_amdgcn_ballot_w64(tmx > THR) != 0ull) {
                const float delta = (first || tmx > THR) ? tmx : 0.f;
                const float corr = first ? 1.f : __builtin_amdgcn_exp2f(-delta);
                m_run += delta; lacc[0] *= corr;
#pragma unroll
                for (int i = 0; i < 16; ++i) { oacc[0][i] *= corr; oacc[1][i] *= corr; s[0][i] -= delta; s[1][i] -= delta; }
            }
        }
    };
    auto SBRUN = [&](const f32x16& sv, int ks, int run, u32x4 (&pf)[4]) {
        float rb[8];
#pragma unroll
        for (int i = 0; i < 8; ++i) {
            const float e = __builtin_amdgcn_exp2f(sv[8 * run + i]);
            rb[i] = __builtin_amdgcn_rcpf(1.f + e);
        }
        const float p = ((rb[0] * rb[1]) * (rb[2] * rb[3])) * ((rb[4] * rb[5]) * (rb[6] * rb[7]));
        const float pp = shx(p, 32, lane);
        float c = R * (hh == 0 ? pp : 1.f);
        unsigned wd[4];
#pragma unroll
        for (int i = 3; i >= 0; --i) {
            const float ch = c * rb[2 * i + 1], ah = c - ch;
            const float cl = ch * rb[2 * i], al = ch - cl;
            c = cl; wd[i] = pk2z(al, ah);
        }
        u32x4 t; t.x = wd[0]; t.y = wd[1]; t.z = wd[2]; t.w = wd[3]; pf[2 * ks + run] = t;
        R *= p * pp;
    };
    auto CD = [&](f32x16 (&s)[2], int it) {
        u32x4 pf[4];
        if constexpr (MODE == 1) {
#pragma unroll
            for (int ks = 1; ks >= 0; --ks) { SBRUN(s[ks], ks, 1, pf); __builtin_amdgcn_sched_barrier(0); SBRUN(s[ks], ks, 0, pf); __builtin_amdgcn_sched_barrier(0); }
        } else {
#pragma unroll
            for (int ks = 0; ks < 2; ++ks) {
                float p[16];
#pragma unroll
                for (int r = 0; r < 16; ++r) p[r] = __builtin_amdgcn_exp2f(s[ks][r]);
#pragma unroll
                for (int run = 0; run < 2; ++run) { u32x4 t; t.x = pk2z(p[8 * run], p[8 * run + 1]); t.y = pk2z(p[8 * run + 2], p[8 * run + 3]); t.z = pk2z(p[8 * run + 4], p[8 * run + 5]); t.w = pk2z(p[8 * run + 6], p[8 * run + 7]); pf[2 * ks + run] = t; }
            }
        }
#pragma unroll
        for (int st = 0; st < 4; ++st) {
            const h16x8 pb = __builtin_bit_cast(h16x8, pf[st]);
#pragma unroll
            for (int dvt = 0; dvt < 2; ++dvt) {
                const LAS unsigned char* vb = lds + AT_VOFF + (it & 1) * AT_VBYTES + (32 * dvt + j) * VRS + st * 32 + hh * 16;
                oacc[dvt] = __builtin_amdgcn_mfma_f32_32x32x16_f16(*(const LAS h16x8*)vb, pb, oacc[dvt], 0, 0, 0);
            }
            if constexpr (MODE != 1) lacc = __builtin_amdgcn_mfma_f32_32x32x16_f16(onesf, pb, lacc, 0, 0, 0);
        }
    };
    auto FUSED = [&](f32x16 (&sc)[2], f32x16 (&sn)[2], int it) {
        constexpr int NA = 2 * NDS, NCH = NA > 8 ? NA : 8;
        const int ktn = nkt - 2 - it;
#pragma unroll
        for (int ks = 0; ks < 2; ++ks) {
            if constexpr (MODE == 2) {
                const float base = dt - m_run;
#pragma unroll
                for (int run = 0; run < 2; ++run) {
                    const LAS float* dk = DC + 64 * ktn + 32 * ks + 16 * run + 8 * hh;
                    const f32x4 d0 = *(const LAS f32x4*)dk, d1 = *(const LAS f32x4*)(dk + 4);
#pragma unroll
                    for (int e = 0; e < 4; ++e) { sn[ks][8 * run + e] = base - d0[e]; sn[ks][8 * run + 4 + e] = base - d1[e]; }
                }
            } else {
                const float base = (MODE == 0) ? -m_run : 0.f;
#pragma unroll
                for (int r = 0; r < 16; ++r) sn[ks][r] = base;
            }
        }
        const LAS unsigned char* kb = lds + ((it + 1) & 1) * AT_KBYTES + pij * KRS + hh * 16;
        const LAS unsigned char* vb = lds + AT_VOFF + (it & 1) * AT_VBYTES + j * VRS + hh * 16;
        h16x8 kf[NA];
        constexpr int PD = 4;
#pragma unroll
        for (int k = 0; k < PD; ++k) kf[k] = *(const LAS h16x8*)(kb + (k / NDS) * 32 * KRS + (k % NDS) * 32);
        u32x4 pf[4]; float pv[8];
        __builtin_amdgcn_sched_barrier(0);
#pragma unroll
        for (int k = 0; k < NCH; ++k) {
            if (k + PD < NA) kf[k + PD] = *(const LAS h16x8*)(kb + ((k + PD) / NDS) * 32 * KRS + ((k + PD) % NDS) * 32);
#ifdef PROBE_LDS
            if (k + 2 < NA) { const volatile LAS u32x4* dp = (const volatile LAS u32x4*)(kb + ((k + 2) / NDS) * 32 * KRS + ((k + 2) % NDS) * 32); u32x4 dd = *dp; asm volatile("" :: "v"(dd)); }
#endif
            if (k < NA) sn[k / NDS] = __builtin_amdgcn_mfma_f32_32x32x16_f16(kf[k], qf[k % NDS], sn[k / NDS], 0, 0, 0);
            if (k < 8) {
                const int ks = k >> 2;
#pragma unroll
                for (int e = 0; e < 4; ++e) {
                    const int r = 4 * (k & 3) + e;
                    { const float p = __builtin_amdgcn_exp2f(sc[ks][r]); pv[4 * (k & 1) + e] = p; }
#ifdef PROBE_VALU
                    { float zz = sc[ks][r]; asm volatile("" : "+v"(zz)); const float p2 = __builtin_amdgcn_exp2f(zz); float acc2 = p2 + 1.0f; asm volatile("" :: "v"(acc2)); }
#endif
                }
                if constexpr (MODE != 1) { if (k & 1) { u32x4 t; t.x = pk2z(pv[0], pv[1]); t.y = pk2z(pv[2], pv[3]); t.z = pk2z(pv[4], pv[5]); t.w = pk2z(pv[6], pv[7]); pf[k >> 1] = t; } }
            }
            __builtin_amdgcn_sched_barrier(0);
        }
        h16x8 vf[8];
#pragma unroll
        for (int k = 0; k < PD; ++k) vf[k] = *(const LAS h16x8*)(vb + (k & 1) * 32 * VRS + (k >> 1) * 32);
        float tmx = -3e38f;
        __builtin_amdgcn_sched_barrier(0);
#pragma unroll
        for (int k = 0; k < 8; ++k) {
            if (k + PD < 8) vf[k + PD] = *(const LAS h16x8*)(vb + ((k + PD) & 1) * 32 * VRS + ((k + PD) >> 1) * 32);
            oacc[k & 1] = __builtin_amdgcn_mfma_f32_32x32x16_f16(vf[k], __builtin_bit_cast(h16x8, pf[k >> 1]), oacc[k & 1], 0, 0, 0);
            if constexpr (MODE != 1) { if (k & 1) lacc = __builtin_amdgcn_mfma_f32_32x32x16_f16(onesf, __builtin_bit_cast(h16x8, pf[k >> 1]), lacc, 0, 0, 0); }
            if constexpr (MODE != 1) {
                const int ks = k >> 2, r0 = 4 * (k & 3);
                tmx = fmaxf(fmaxf(tmx, sn[ks][r0]), sn[ks][r0 + 1]); tmx = fmaxf(fmaxf(tmx, sn[ks][r0 + 2]), sn[ks][r0 + 3]);
            }
            __builtin_amdgcn_sched_barrier(0);
        }
        if constexpr (MODE != 1) {
            tmx = fmaxf(tmx, shx(tmx, 32, lane));
            if (__builtin_expect(__builtin_amdgcn_ballot_w64(tmx > THR) != 0ull, 0)) {
                const float delta = (tmx > THR) ? tmx : 0.f;
                const float corr = __builtin_amdgcn_exp2f(-delta);
                m_run += delta; lacc[0] *= corr;
#pragma unroll
                for (int i = 0; i < 16; ++i) { oacc[0][i] *= corr; oacc[1][i] *= corr; sn[0][i] -= delta; sn[1][i] -= delta; }
            }
        }
    };
    auto BMAXFIRST = [&](f32x16 (&s)[2]) {
        if constexpr (MODE != 1) {
            float tmx = fmaxf(s[0][0], s[1][0]);
#pragma unroll
            for (int r = 1; r < 16; ++r) tmx = fmaxf(fmaxf(tmx, s[0][r]), s[1][r]);
            tmx = fmaxf(tmx, shx(tmx, 32, lane));
            m_run += tmx;
#pragma unroll
            for (int i = 0; i < 16; ++i) { s[0][i] -= tmx; s[1][i] -= tmx; }
        }
    };
    auto kofs = [&](int t) -> int { const int r = t % 3; return r == 2 ? AT_DCOFF : r * AT_KBYTES; };
    auto SUB = [&](f32x16& sv, int ks, int t, bool diag) {
#pragma unroll
        for (int r = 0; r < 16; ++r) sv[r] = 0.f;
        if (diag) {
#pragma unroll
            for (int r = 0; r < 16; ++r) { const int kq = 32 * ks + 16 * (r >> 3) + 8 * hh + (r & 7); if (kq >= tqd) sv[r] = -1e30f; }
        }
        const LAS unsigned char* kb = lds + kofs(t) + (32 * ks + pij) * KRS + hh * 16;
        h16x8 kq4[NDS];
#pragma unroll
        for (int ds = 0; ds < NDS; ++ds) kq4[ds] = *(const LAS h16x8*)(kb + ds * 32);
#pragma unroll
        for (int ds = 0; ds < NDS; ++ds) sv = __builtin_amdgcn_mfma_f32_32x32x16_f16(kq4[ds], qf[ds], sv, 0, 0, 0);
    };
    auto PVRUN = [&](int st, int t, const u32x4& pw) {
        const h16x8 pb = __builtin_bit_cast(h16x8, pw);
#pragma unroll
        for (int dvt = 0; dvt < 2; ++dvt) {
            const LAS unsigned char* vb = lds + AT_VOFF + (t & 1) * AT_VBYTES + (32 * dvt + j) * VRS + st * 32 + hh * 16;
            oacc[dvt] = __builtin_amdgcn_mfma_f32_32x32x16_f16(*(const LAS h16x8*)vb, pb, oacc[dvt], 0, 0, 0);
        }
    };
    auto STEP = [&](int it, f32x16 (&sc)[2], f32x16 (&sn)[2], StageRegs& rl, StageRegs& rs) {
        if constexpr (MODE == 1) { gloadK(max(nkt - 3 - it, 0), rs); gloadV(max(nkt - 2 - it, 0), rs); }
        else { gloadK(max(nkt - 4 - it, 0), rl); gloadV(max(nkt - 3 - it, 0), rl); }
        const bool act = it >= it0, actn = (it + 1 < nkt) && (it + 1 >= it0);
        if constexpr (MODE == 1) {
            u32x4 pf[4];
            if (act) {
                SUB(sc[0], 0, it, it == it0);
                SBRUN(sc[1], 1, 1, pf); PVRUN(3, it, pf[3]); __builtin_amdgcn_sched_barrier(0);
                SBRUN(sc[1], 1, 0, pf); PVRUN(2, it, pf[2]); __builtin_amdgcn_sched_barrier(0);
            }
            if (actn) SUB(sn[1], 1, it + 1, it + 1 == it0);
            if (act) {
                SBRUN(sc[0], 0, 1, pf); PVRUN(1, it, pf[1]); __builtin_amdgcn_sched_barrier(0);
                SBRUN(sc[0], 0, 0, pf); PVRUN(0, it, pf[0]);
            }
        } else if (act && actn) FUSED(sc, sn, it);
        else if (actn) { ST(sn, it + 1, std::true_type{}); BMAXFIRST(sn); }
        if constexpr (MODE == 1) { if (it + 2 < nkt) *(LAS u32x4*)(lds + kofs(it + 2) + srow * KRS + sch * 16) = rs.k0; if (it + 1 < nkt) lstoreV((it + 1) & 1, rs); }
        else {
        if (it + 2 < nkt) lstoreK(it & 1, rs);
        if (it + 1 < nkt) lstoreV((it + 1) & 1, rs);
        }
        lds_barrier();
    };
    lstoreK(0, RA); lstoreV(0, RA); lstoreK(1, RB);
    if constexpr (MODE != 1) { gloadK(nkt - 3, RB); gloadV(nkt - 2, RB); }
    lds_barrier();
    f32x16 sa[2], sb[2];
#pragma unroll
    for (int i = 0; i < 16; ++i) { sa[0][i] = 0.f; sa[1][i] = 0.f; sb[0][i] = 0.f; sb[1][i] = 0.f; }
    if constexpr (MODE != 1) { if (it0 == 0) { ST(sa, 0, std::true_type{}); BMAXFIRST(sa); } }
    else { if (it0 == 0) SUB(sa[1], 1, 0, true); }
    lds_barrier();
    for (int it = 0; it < nkt; it += 2) { STEP(it, sa, sb, RA, RB); STEP(it + 1, sb, sa, RB, RA); }
    if constexpr (MODE != 1) CD(sb, nkt - 1);
    float inv = 1.f;
    if constexpr (MODE != 1) { const float l0 = lacc[0], lp = shx(l0, 32, lane); inv = 1.f / (hh ? lp : l0); }
    h16* op = Og + ((size_t)b * SEQ + qw + j) * DM + ocol + 4 * hh;
#pragma unroll
    for (int dvt = 0; dvt < 2; ++dvt)
#pragma unroll
        for (int g = 0; g < 4; ++g) {
            f32x4 v; v[0] = oacc[dvt][4 * g] * inv; v[1] = oacc[dvt][4 * g + 1] * inv; v[2] = oacc[dvt][4 * g + 2] * inv; v[3] = oacc[dvt][4 * g + 3] * inv;
            *(u32x2*)(op + 32 * dvt + 8 * g) = pk4(v);
        }
}

template <class F>
__device__ __forceinline__ void prep_w(LAS unsigned char* lds, h16* dst, int Nd, int K, int Ns, const float* kscale, F colptr, int cid, int G, int tid,
                                       float* c1 = nullptr, float* c2 = nullptr, const float* lnb = nullptr) {
    constexpr int NT = 4;
    const int tn = Nd >> 6, tk = K >> 6, ntiles = tn * tk;
    const int rn = tid & 63, rk = tid >> 6;
    const int wn = tid >> 3, wc = tid & 7;
    const float* dummy = colptr(0);
    for (int t0 = cid; t0 < ntiles; t0 += NT * G) {
        float v[NT][8]; bool nul[NT];
#pragma unroll
        for (int q = 0; q < NT; ++q) {
            const int t = min(t0 + q * G, ntiles - 1);
            const int n0 = (t % tn) << 6, k0 = (t / tn) << 6;
            const float* col = colptr(n0 + rn); nul[q] = (col == nullptr); if (nul[q]) col = dummy;
#pragma unroll
            for (int i = 0; i < 8; ++i) v[q][i] = col[(size_t)(k0 + rk + 8 * i) * Ns];
        }
#pragma unroll
        for (int q = 0; q < NT; ++q) {
            const int t = min(t0 + q * G, ntiles - 1);
            const int k0 = (t / tn) << 6;
            LAS h16* tile = (LAS h16*)lds + q * (64 * 72);
#pragma unroll
            for (int i = 0; i < 8; ++i) { float x = nul[q] ? 0.f : v[q][i]; if (kscale) x *= kscale[k0 + rk + 8 * i]; tile[rn * 72 + rk + 8 * i] = (h16)x; }
        }
        __syncthreads();
#pragma unroll
        for (int q = 0; q < NT; ++q) {
            const int t = t0 + q * G;
            if (t < ntiles) {
                const int n0 = (t % tn) << 6, k0 = (t / tn) << 6;
                LAS h16* tile = (LAS h16*)lds + q * (64 * 72);
                const u32x4 w = *(const LAS u32x4*)(tile + wn * 72 + wc * 8);
                *(u32x4*)(dst + (size_t)(n0 + wn) * K + k0 + wc * 8) = w;
                if (c1) {
                    const h16x8 hv = __builtin_bit_cast(h16x8, w);
                    float a1 = 0.f, a2 = 0.f;
#pragma unroll
                    for (int e = 0; e < 8; ++e) { const int kk = k0 + wc * 8 + e; const float f = (float)hv[e]; a1 += f; a2 += f * (lnb[kk] / kscale[kk]); }
                    const int ln = tid & 63;
                    a1 += shx(a1, 1, ln); a1 += shx(a1, 2, ln); a1 += shx(a1, 4, ln);
                    a2 += shx(a2, 1, ln); a2 += shx(a2, 2, ln); a2 += shx(a2, 4, ln);
                    if (wc == 0) { atomicAdd(c1 + n0 + wn, a1); atomicAdd(c2 + n0 + wn, a2); }
                }
            }
        }
        __syncthreads();
    }
}
__device__ __forceinline__ void cvt_rows(h16* dst, const float* src, size_t n8, int gtid, int gthreads) {
    size_t i = gtid;
    for (; i + 3 * (size_t)gthreads < n8; i += 4 * (size_t)gthreads) {
        f32x4 a[4], c[4];
#pragma unroll
        for (int q = 0; q < 4; ++q) { const size_t k = i + (size_t)q * gthreads; a[q] = __builtin_nontemporal_load((const f32x4*)(src + k * 8)); c[q] = __builtin_nontemporal_load((const f32x4*)(src + k * 8 + 4)); }
#pragma unroll
        for (int q = 0; q < 4; ++q) { const size_t k = i + (size_t)q * gthreads;
            u32x4 w; w.x = pk2(a[q][0], a[q][1]); w.y = pk2(a[q][2], a[q][3]); w.z = pk2(c[q][0], c[q][1]); w.w = pk2(c[q][2], c[q][3]);
            *(u32x4*)(dst + k * 8) = w; }
    }
    for (; i < n8; i += gthreads) {
        const f32x4 a = *(const f32x4*)(src + i * 8), c = *(const f32x4*)(src + i * 8 + 4);
        u32x4 w; w.x = pk2(a[0], a[1]); w.y = pk2(a[2], a[3]); w.z = pk2(c[0], c[1]); w.w = pk2(c[2], c[3]);
        *(u32x4*)(dst + i * 8) = w;
    }
}
__device__ __forceinline__ void sincos_d(double r, double& s, double& c) {
    const double r2 = r * r; double ts = r, tc = 1.0; s = r; c = 1.0;
#pragma unroll 1
    for (int n = 1; n <= 14; ++n) { tc *= -r2 / (double)((2 * n - 1) * (2 * n)); c += tc; ts *= -r2 / (double)((2 * n) * (2 * n + 1)); s += ts; }
}

__device__ __forceinline__ void ln_phase(const float* __restrict__ Y, float* __restrict__ XF, h16* __restrict__ XB, const float* __restrict__ g, const float* __restrict__ bt, int wave_id) {
    int lane_ = lane_id_opaque(); asm volatile("" : "+v"(lane_));
    const int lane = lane_, wg = blockIdx.x * 8 + wave_id, nw = gridDim.x * 8;
    f32x4 gv[4], bv[4];
#pragma unroll
    for (int i = 0; i < 4; ++i) { gv[i] = *(const f32x4*)(g + (i * 64 + lane) * 4); bv[i] = *(const f32x4*)(bt + (i * 64 + lane) * 4); }
    for (int row = wg; row < T; row += nw) {
        const float* y = Y + (size_t)row * DM; f32x4 v[4]; float s = 0.f;
#pragma unroll
        for (int i = 0; i < 4; ++i) { v[i] = *(const f32x4*)(y + (i * 64 + lane) * 4); s += (v[i][0] + v[i][1]) + (v[i][2] + v[i][3]); }
#pragma unroll
        for (int off = 32; off >= 1; off >>= 1) s += shx(s, off, lane);
        const float mean = s * (1.f / 1024.f); float q = 0.f;
#pragma unroll
        for (int i = 0; i < 4; ++i) { v[i] = v[i] - mean; q += (v[i][0] * v[i][0] + v[i][1] * v[i][1]) + (v[i][2] * v[i][2] + v[i][3] * v[i][3]); }
#pragma unroll
        for (int off = 32; off >= 1; off >>= 1) q += shx(q, off, lane);
        const float rstd = 1.0f / sqrtf(q * (1.f / 1024.f) + 1e-5f);
#pragma unroll
        for (int i = 0; i < 4; ++i) {
            const f32x4 o = v[i] * rstd * gv[i] + bv[i];
            *(f32x4*)(XF + (size_t)row * DM + (i * 64 + lane) * 4) = o;
            *(u32x2*)(XB + (size_t)row * DM + (i * 64 + lane) * 4) = pk4(o);
        }
    }
}

#define XB_TMO      128
#define XB_XCNT(j)  (256  + 64 * (j))
#define XB_XSUB(j)  (1280 + 64 * (j))
#define XB_XGEN(j)  (2304 + 64 * (j))
#define XB_TOP      3328
#define XB_TOPGEN   3392
#define XCD_BAR_WORDS 3456
#define XB_SPIN_CAP (1u << 22)
__device__ __forceinline__ unsigned xb_ld(unsigned* p)              { return __hip_atomic_load(p, __ATOMIC_RELAXED, __HIP_MEMORY_SCOPE_AGENT); }
__device__ __forceinline__ unsigned xb_add(unsigned* p, unsigned v) { return __hip_atomic_fetch_add(p, v, __ATOMIC_RELAXED, __HIP_MEMORY_SCOPE_AGENT); }
__device__ __forceinline__ unsigned xb_xcc_id() { return (unsigned)__builtin_amdgcn_s_getreg((3 << 11) | 20) & 0xFu; }
#define XB_SPIN(cond, bar) do { unsigned _sp = 0; while (cond) { __builtin_amdgcn_s_sleep(1); \
    if ((++_sp & 255u) == 0u) { if (xb_ld(&(bar)[XB_TMO])) break; if (_sp > XB_SPIN_CAP) { atomicAdd(&(bar)[XB_TMO], 1u); break; } } } } while (0)
__device__ __forceinline__ bool xb_leader(int wave_id) { return wave_id == 0 && lane_id_opaque() == 0; }
__device__ __forceinline__ void xcd_barrier_complete(unsigned* bar, unsigned x, unsigned G, unsigned& nloc, unsigned& nx) {
    unsigned sum, cnt, mine, sp = 0u;
    for (;;) {
        sum = 0u; cnt = 0u; mine = 0u;
#pragma unroll
        for (unsigned j = 0; j < 16; ++j) { const unsigned c = xb_ld(&bar[XB_XCNT(j)]); sum += c; cnt += (c > 0u) ? 1u : 0u; mine = (j == x) ? c : mine; }
        if (sum == G) break;
        __builtin_amdgcn_s_sleep(1);
        if ((++sp & 255u) == 0u) { if (xb_ld(&bar[XB_TMO])) break; if (sp > XB_SPIN_CAP) { atomicAdd(&bar[XB_TMO], 1u); break; } }
    }
    nloc = mine > 0u ? mine : 1u; nx = cnt > 0u ? cnt : 1u;
}
__device__ __forceinline__ void grid_barrier(unsigned* bar, volatile LAS unsigned* st, unsigned G, int wave_id) {
    asm volatile("s_waitcnt vmcnt(0)" ::: "memory");
    __syncthreads();
    if (xb_leader(wave_id)) {
        const unsigned x = xb_xcc_id();
        __builtin_amdgcn_s_waitcnt(0);
        unsigned nloc = st[0], nx = st[1];
        if (nloc == 0u) { xcd_barrier_complete(bar, x, G, nloc, nx); st[0] = nloc; st[1] = nx; }
        const unsigned old = xb_add(&bar[XB_XSUB(x)], 1u);
        const unsigned gen = old / nloc;
        if (old + 1u == (gen + 1u) * nloc) {
            __builtin_amdgcn_fence(__ATOMIC_RELEASE, "agent");
            asm volatile("s_waitcnt vmcnt(0)" ::: "memory");
            const unsigned og = xb_add(&bar[XB_TOP], 1u);
            const unsigned tg = og / nx;
            if (og + 1u == (tg + 1u) * nx) xb_add(&bar[XB_TOPGEN], 1u);
            else XB_SPIN(xb_ld(&bar[XB_TOPGEN]) == tg, bar);
            __builtin_amdgcn_fence(__ATOMIC_ACQUIRE, "agent");
            xb_add(&bar[XB_XGEN(x)], 1u);
            asm volatile("s_waitcnt vmcnt(0)" ::: "memory");
        } else {
            XB_SPIN(xb_ld(&bar[XB_XGEN(x)]) == gen, bar);
            __builtin_amdgcn_fence(__ATOMIC_ACQUIRE, "agent");
            asm volatile("s_waitcnt vmcnt(0)" ::: "memory");
        }
    }
    __syncthreads();
}

struct Args { const float* in[21]; float* out; unsigned char* ws; int ph_lo, ph_hi; };

__global__ void __launch_bounds__(512) mega(Args a) {
    extern __shared__ __attribute__((aligned(16))) unsigned char lds_raw[];
    LAS unsigned char* lds = (LAS unsigned char*)lds_raw;
    const int G0 = gridDim.x, cid0 = blockIdx.x;
    const int wave_id = __builtin_amdgcn_readfirstlane((int)threadIdx.x >> 6);
    if (a.ph_hi > 4096) cg::this_grid().sync();
    volatile LAS unsigned* bar_st = (volatile LAS unsigned*)(lds + 131072);
    if (xb_leader(wave_id)) { bar_st[0] = 0u; bar_st[1] = 0u; if (a.ph_hi - a.ph_lo > 1) (void)xb_add((unsigned*)(a.ws + WS_BAR) + XB_XCNT(xb_xcc_id()), 1u); }
    __syncthreads();

#ifndef REP_MASK
#define REP_MASK 0
#endif
    for (int pp = a.ph_lo * 2; pp < a.ph_hi * 2; ++pp) {
        const int p = pp >> 1;
        if ((pp & 1) && !((REP_MASK >> p) & 1)) continue;
        const __attribute__((address_space(4))) Args* ap = (const __attribute__((address_space(4))) Args*)__builtin_amdgcn_kernarg_segment_ptr(); asm volatile("" : "+s"(ap));
        int G = G0, cid = cid0; asm volatile("" : "+s"(G), "+s"(cid));
        unsigned char* ws = ap->ws;
    float* SSQ = (float*)(ws + WS_SSQ); float* ROPE = (float*)(ws + WS_ROPE);
    h16* WINA = (h16*)(ws + WS_WINA); h16* WUQ = (h16*)(ws + WS_WUQ); h16* WUKV = (h16*)(ws + WS_WUKV); h16* WOUTA = (h16*)(ws + WS_WOUTA);
    h16* WINC = (h16*)(ws + WS_WINC); h16* WOUTC = (h16*)(ws + WS_WOUTC); h16* W13 = (h16*)(ws + WS_W13); h16* W2 = (h16*)(ws + WS_W2);
    h16* WG = (h16*)(ws + WS_WG); h16* WP = (h16*)(ws + WS_WP);
    float* FLT = (float*)(ws + WS_FLT); h16* PB = (h16*)(ws + WS_PB); h16* XBA = (h16*)(ws + WS_XBA); h16* XBB = (h16*)(ws + WS_XBB);
    h16* U = (h16*)(ws + WS_U); float* XF = (float*)(ws + WS_XF); float* Y = ap->out;
    float* STATS = (float*)(ws + WS_STATS); float* CVEC = (float*)(ws + WS_CVEC);
    h16* CQ = (h16*)(ws + WS_CQ); h16* CKV = (h16*)(ws + WS_CKV); h16* QA = (h16*)(ws + WS_QA); h16* KA = (h16*)(ws + WS_KA); h16* VAT = (h16*)(ws + WS_VAT);
    h16* QB = (h16*)(ws + WS_QB); h16* KB = (h16*)(ws + WS_KB); h16* VBT = (h16*)(ws + WS_VBT); h16* OCAT = (h16*)(ws + WS_OCAT);
    h16* Q1 = (h16*)(ws + WS_Q1); h16* K1 = (h16*)(ws + WS_K1); h16* VT1 = (h16*)(ws + WS_VT1);
        int q = p, L = 0;
        if (p >= 12) { q = p - 8; L = 1; }
        if (PH_EN(0) && p == 0) {
            int tid0 = wave_id * 64 + lane_id_opaque(); asm volatile("" : "+v"(tid0));
            int gthreads = G * 512; asm volatile("" : "+s"(gthreads));
            const int gtid = cid * 512 + tid0;
            { const float* w = ap->in[2];
              prep_w(lds, WINA, NIN_A, 1024, 2080, nullptr, [=](int n) -> const float* { return n < 1536 ? w + 544 + n : n < 2048 ? w + (n - 1536) : n < 2080 ? w + 512 + (n - 2048) : nullptr; }, cid, G, tid0); }
            { const float* w = ap->in[4]; prep_w(lds, WUQ, 768, 256, 768, ap->in[3], [=](int n) -> const float* { return w + n; }, cid, G, tid0); }
            { const float* w = ap->in[6]; prep_w(lds, WUKV, 1024, 256, 1024, ap->in[5], [=](int n) -> const float* { return w + n; }, cid, G, tid0); }
            { const float* w = ap->in[7]; prep_w(lds, WOUTA, 1024, 1024, 1024, nullptr, [=](int n) -> const float* { return w + n; }, cid, G, tid0); }
            { const float* w = ap->in[8]; prep_w(lds, WINC, NIN_C, 1024, 3088, nullptr, [=](int n) -> const float* { return n < 3088 ? w + n : nullptr; }, cid, G, tid0); }
            { const float* w = ap->in[10]; prep_w(lds, WOUTC, 1024, 1024, 1024, nullptr, [=](int n) -> const float* { return w + n; }, cid, G, tid0); }
            for (int l = 0; l < 2; ++l) {
                { const float* w1 = ap->in[11] + (size_t)l * 1024 * DFF; const float* w3 = ap->in[12] + (size_t)l * 1024 * DFF;
                  prep_w(lds, W13 + (size_t)l * 5632 * 1024, 5632, 1024, DFF, ap->in[14] + l * DM, [=](int n) -> const float* { const int tl = n >> 8, r = n & 255; return w1 + (r < 128 ? (ptrdiff_t)0 : (w3 - w1)) + tl * 128 + (r & 127); }, cid, G, tid0,
                         CVEC + (size_t)(l * 2) * CV_N, CVEC + (size_t)(l * 2 + 1) * CV_N, ap->in[15] + l * DM); }
                { const float* w = ap->in[13] + (size_t)l * DFF * 1024; prep_w(lds, W2 + (size_t)l * 1024 * DFF, 1024, DFF, 1024, nullptr, [=](int n) -> const float* { return w + n; }, cid, G, tid0); }
                { const float* w = ap->in[19] + (size_t)l * 1024 * 1024; prep_w(lds, WG + (size_t)l * 1024 * 1024, 1024, 1024, 1024, ap->in[16] + l * DM, [=](int n) -> const float* { return w + n; }, cid, G, tid0,
                         CVEC + (size_t)(l * 2) * CV_N + 5632, CVEC + (size_t)(l * 2 + 1) * CV_N + 5632, ap->in[17] + l * DM); }
                { const float* w = ap->in[18] + (size_t)l * 256 * 1024; prep_w(lds, WP + (size_t)l * 1024 * 256, 1024, 256, 1024, nullptr, [=](int n) -> const float* { return w + n; }, cid, G, tid0); }
            }
            cvt_rows(XBA, ap->in[0], (size_t)T * DM / 8, gtid, gthreads);
            cvt_rows(PB, ap->in[1], (size_t)2 * T * PD / 8, gtid, gthreads);
            { float zf = 0.f; asm volatile("" : "+v"(zf)); for (int i = gtid; i < T * 2; i += gthreads) SSQ[i] = zf; }
            for (int i = gtid; i < SEQ * 16; i += gthreads) {
                const int pos = i >> 4, fi = i & 15;
                double invd = 1.0;
#pragma unroll 1
                for (int e = 0; e < fi; ++e) invd *= 0.56234132519034907;
                const float inv = (float)invd;
                const float ang = (float)pos * inv;
                const double ad = (double)ang, k = rint(ad * 0.15915494309189535);
                const double r = (ad - k * 6.283185307179586) - k * 2.4492935982947064e-16;
                double sn, cs; sincos_d(r, sn, cs);
                ROPE[2 * i] = (float)cs; ROPE[2 * i + 1] = (float)sn;
            }
        } else if (PH_EN(1) && p == 1) {
            pg8::Gemm g{XBA, WINA, T, NIN_A, 1024}; pg8::StaticOrder S; S.init(T, NIN_A, G, cid);
            EpiInA E{QB, KB, VBT, CQ, CKV, KA, SSQ, ROPE};
            pg8::gemm_phase(lds, g, S, E, wave_id);
        } else if (PH_EN(2) && p == 2) {
            { pg8::Gemm g{CQ, WUQ, T, 768, 256}; pg8::StaticOrder S; S.init(T, 768, G, cid); EpiUq E{QA, SSQ, ROPE}; pg8::gemm_phase(lds, g, S, E, wave_id); }
            { pg8::Gemm g{CKV, WUKV, T, 1024, 256}; pg8::StaticOrder S; S.init(T, 1024, G, cid); EpiUkv E{KA, VAT, SSQ}; pg8::gemm_phase(lds, g, S, E, wave_id); }
        } else if (PH_EN(3) && p == 3) {
            for (int r = 0;; ++r) {
                const int u = r * G + ((r & 1) ? G - 1 - cid : cid);
                if (u >= 2048) break;
                const int qb = 15 - (u >> 7), sub = u & 127, bh = sub & 63, b = bh >> 3, h = bh & 7;
#ifndef P3_SKIP
#define P3_SKIP 9
#endif
                if (P3_SKIP != 1 && sub < 64) attn_unit<1>(lds, QB, KB, VBT, OCAT, 512 + h * 64, nullptr, b, bh, qb, wave_id);
                else if (P3_SKIP != 0) attn_unit<0>(lds, QA, KA, VAT, OCAT, h * 64, nullptr, b, bh, qb, wave_id);
            }
        } else if (PH_EN(10) && p == 10) {
            pg8::Gemm g{XBB, WINC, T, NIN_C, 1024}; pg8::StaticOrder S; S.init(T, NIN_C, G, cid);
            EpiInC E{Q1, K1, VT1, FLT, ap->in[9]};
            pg8::gemm_phase(lds, g, S, E, wave_id);
        } else if (PH_EN(11) && p == 11) {
            for (int r = 0;; ++r) {
                const int u = r * G + ((r & 1) ? G - 1 - cid : cid);
                if (u >= 2048) break;
                const int qb = 15 - (u >> 7), bh = u & 127, b = bh >> 4, h = bh & 15;
                attn_unit<2>(lds, Q1, K1, VT1, OCAT, h * 64, FLT, b, bh, qb, wave_id);
            }
        } else if (PH_EN(4) && (q == 4 || q == 7)) {
            pg8::Gemm g; EpiResLn E;
            if (q == 4) { g = pg8::Gemm{OCAT, L ? WOUTC : WOUTA, T, DM, 1024};
                          E = EpiResLn{L ? XBB : XBA, nullptr, nullptr, nullptr, nullptr, XBA, STATS + (size_t)(L * 2) * T * 2}; }
            else { g = pg8::Gemm{U, W2 + (size_t)L * 1024 * DFF, T, DM, DFF};
                   E = EpiResLn{nullptr, XBA, STATS + (size_t)(L * 2) * T * 2, ap->in[14] + L * DM, ap->in[15] + L * DM, XBA, STATS + (size_t)(L * 2 + 1) * T * 2}; }
            pg8::StaticOrder S; S.init(T, DM, G, cid);
            pg8::gemm_phase(lds, g, S, E, wave_id);
        } else if (q == 5 || q == 8) {
            continue;
        } else if (PH_EN(6) && q == 6) {
            pg8::Gemm g{XBA, W13 + (size_t)L * 5632 * 1024, T, 5632, 1024}; pg8::StaticOrder S; S.init(T, 5632, G, cid);
            EpiSwiglu E{U, STATS + (size_t)(L * 2) * T * 2, CVEC + (size_t)(L * 2) * CV_N, CVEC + (size_t)(L * 2 + 1) * CV_N};
            pg8::gemm_phase(lds, g, S, E, wave_id);
        } else if (PH_EN(9) && q == 9) {
            pg8::StaticOrder S; S.init(T, DM, G, cid);
            { pg8::Gemm g{PB + (size_t)L * T * PD, WP + (size_t)L * 1024 * 256, T, DM, 256}; EpiStoreF32 E{(h16*)(ws + WS_Q1)}; pg8::gemm_phase(lds, g, S, E, wave_id); }
            { pg8::Gemm g{XBA, WG + (size_t)L * 1024 * 1024, T, DM, 1024};
              EpiPle E{XBA, STATS + (size_t)(L * 2 + 1) * T * 2, ap->in[16] + L * DM, ap->in[17] + L * DM, CVEC + (size_t)(L * 2) * CV_N + 5632, CVEC + (size_t)(L * 2 + 1) * CV_N + 5632, Y, ap->in[20] + L * DM, L ? nullptr : XBB, (const h16*)(ws + WS_Q1)};
              pg8::gemm_phase(lds, g, S, E, wave_id); }
        }
        if (pp + 1 < a.ph_hi * 2) grid_barrier((unsigned*)(ws + WS_BAR), bar_st, (unsigned)G, wave_id);
    }
}

extern "C" void kernel_launch(void* const* d_in, const int* in_sizes, int n_in, void* d_out, int out_size, void* d_ws, size_t ws_size, hipStream_t stream) {
    static int grid = 0;
    if (grid == 0) {
        if (n_in != 21 || out_size != T * DM || ws_size < WS_END) { fprintf(stderr, "kernel_launch: unexpected problem (n_in %d, out %d, ws %zu)\n", n_in, out_size, ws_size); grid = -1; return; }
        int dev = 0, cus = 0, per_cu = 0;
        hipGetDevice(&dev); hipDeviceGetAttribute(&cus, hipDeviceAttributeMultiprocessorCount, dev);
        if (hipFuncSetAttribute((const void*)mega, hipFuncAttributeMaxDynamicSharedMemorySize, LDS_BYTES) != hipSuccess) { fprintf(stderr, "kernel_launch: hipFuncSetAttribute failed\n"); grid = -1; return; }
        if (hipOccupancyMaxActiveBlocksPerMultiprocessor(&per_cu, (const void*)mega, 512, LDS_BYTES) != hipSuccess || per_cu < 1) { fprintf(stderr, "kernel_launch: occupancy query says %d\n", per_cu); per_cu = 1; }
        (void)hipGetLastError();
        grid = cus;
        fprintf(stderr, "kernel_launch: grid %d (per_cu %d)\n", grid, per_cu);
    }
    if (grid < 0) return;
    Args a{};
    for (int i = 0; i < 21; ++i) a.in[i] = (const float*)d_in[i];
    a.out = (float*)d_out; a.ws = (unsigned char*)d_ws;
#if MK_ONE_LAUNCH
    (void)hipMemsetAsync((char*)d_ws + WS_BAR, 0, 16384, stream);
    (void)hipMemsetAsync((char*)d_ws + WS_STATS, 0, WS_ZERO_BYTES, stream);
    a.ph_lo = 0; a.ph_hi = NPHASE;
    void* args[] = {&a};
    hipError_t e = hipLaunchCooperativeKernel((const void*)mega, dim3(grid), dim3(512), args, LDS_BYTES, stream);
    if (e != hipSuccess) fprintf(stderr, "cooperative launch failed: %s (grid %d)\n", hipGetErrorString(e), grid);
#else
    for (int p = 0; p < NPHASE; ++p) {
        a.ph_lo = p; a.ph_hi = p + 1;
        hipLaunchKernelGGL(mega, dim3(grid), dim3(512), LDS_BYTES, stream, a);
    }
#endif
}
```
